# Optimizing an MI355X kernel written in HIP

```python
import math
import jax, jax.numpy as jnp
from jax import lax
import numpy as np

D_MODEL = 1024
BATCH = 4
SEQ = 8192
DEPTH = 1

HEAD_DIM = 64
N_HEADS_A = 8
N_KV_A = 2
GROUP_A = N_HEADS_A // N_KV_A
N_HEADS_B = 8
WINDOW = 128
WIN_BLOCK = 128
T5_BUCKETS = 32
T5_MAX_DIST = 128
GRID_W = 64
NA_ROWS = 8
NA_COLS = 16
PEER_HEADS = 8
PEER_KEYS = 128
N_EXPERTS = PEER_KEYS * PEER_KEYS
PEER_QDIM = 256
PEER_HALF = PEER_QDIM // 2
PEER_TOPK = 16
PEER_CHUNK = 128
EPS = 1e-6
NEG = -1e30

W_QA = N_HEADS_A * HEAD_DIM
W_KVA = N_KV_A * HEAD_DIM
W_B = N_HEADS_B * HEAD_DIM
D_MIX = W_QA + W_B
D_IN = W_QA + 2 * W_KVA + 3 * W_B
IN_SPLITS = [W_QA, W_QA + W_KVA, W_QA + 2 * W_KVA, W_QA + 2 * W_KVA + W_B, W_QA + 2 * W_KVA + 2 * W_B]

kernel_name = "hymba_window_natten_peer_block"


def rms_norm(x, g):
    xf = x.astype(jnp.float32)
    y = xf * lax.rsqrt(jnp.mean(xf * xf, axis=-1, keepdims=True) + EPS)
    return (y * g.astype(jnp.float32)).astype(x.dtype)


def modulate(h, shift, scale):
    return h * (1.0 + scale[:, None, :]) + shift[:, None, :]


def t5_bucket(rel):
    half = T5_BUCKETS // 2
    max_exact = half // 2
    ret = jnp.where(rel > 0, half, 0)
    n = jnp.abs(rel)
    nf = jnp.maximum(n, 1).astype(jnp.float32)
    large = max_exact + (jnp.log(nf / max_exact) / math.log(T5_MAX_DIST / max_exact)
                         * (half - max_exact)).astype(jnp.int32)
    large = jnp.minimum(large, half - 1)
    return ret + jnp.where(n < max_exact, n, large)


def windowed_gqa(q, k, v, sink, t5_table):
    B, S = q.shape[0], q.shape[1]
    nb = S // WIN_BLOCK
    span = WIN_BLOCK + 2 * WINDOW
    pad = ((0, 0), (WINDOW, WINDOW), (0, 0), (0, 0))
    k_pad = jnp.pad(k, pad)
    v_pad = jnp.pad(v, pad)
    i = jnp.arange(WIN_BLOCK)[:, None]
    j = jnp.arange(span)[None, :]
    rel = j - WINDOW - i
    band = jnp.abs(rel) <= WINDOW
    bias = t5_table[t5_bucket(rel)].transpose(2, 0, 1).astype(jnp.float32)
    scale = HEAD_DIM ** -0.5
    sink_f = sink.astype(jnp.float32)

    def block(b):
        qb = lax.dynamic_slice_in_dim(q, b * WIN_BLOCK, WIN_BLOCK, axis=1)
        qb = qb.reshape(B, WIN_BLOCK, N_KV_A, GROUP_A, HEAD_DIM)
        kb = lax.dynamic_slice_in_dim(k_pad, b * WIN_BLOCK, span, axis=1)
        vb = lax.dynamic_slice_in_dim(v_pad, b * WIN_BLOCK, span, axis=1)
        s = jnp.einsum('bqgrd,bkgd->bgrqk', qb, kb).astype(jnp.float32)
        s = s.reshape(B, N_HEADS_A, WIN_BLOCK, span) * scale + bias
        kpos = b * WIN_BLOCK - WINDOW + jnp.arange(span)
        valid = band & ((kpos >= 0) & (kpos < S))[None, :]
        s = jnp.where(valid, s, NEG)
        sink_col = jnp.broadcast_to(sink_f[None, :, None, None], (B, N_HEADS_A, WIN_BLOCK, 1))
        p = jax.nn.softmax(jnp.concatenate([s, sink_col], axis=-1), axis=-1)[..., :span]
        p = p.astype(v.dtype).reshape(B, N_KV_A, GROUP_A, WIN_BLOCK, span)
        o = jnp.einsum('bgrqk,bkgd->bqgrd', p, vb)
        return o.reshape(B, WIN_BLOCK, N_HEADS_A * HEAD_DIM)

    out = lax.map(block, jnp.arange(nb))
    return out.transpose(1, 0, 2, 3).reshape(B, S, N_HEADS_A * HEAD_DIM)


def neighbourhood_attention(q, k, v, rpb):
    B, S = q.shape[0], q.shape[1]
    rows = S // GRID_W
    kr = min(NA_ROWS, rows)
    q_g = q.reshape(B, rows, GRID_W, N_HEADS_B, HEAD_DIM)
    k_g = k.reshape(B, rows, GRID_W, N_HEADS_B, HEAD_DIM)
    v_g = v.reshape(B, rows, GRID_W, N_HEADS_B, HEAD_DIM)
    cols = jnp.arange(GRID_W)
    col_start = jnp.clip(cols - NA_COLS // 2, 0, GRID_W - NA_COLS)
    col_idx = col_start[:, None] + jnp.arange(NA_COLS)[None, :]
    col_off = col_idx - cols[:, None] + (NA_COLS - 1)
    scale = HEAD_DIM ** -0.5
    rpb_f = rpb.astype(jnp.float32)

    def row_block(r):
        rs = jnp.clip(r - kr // 2, 0, rows - kr)
        q_r = lax.dynamic_index_in_dim(q_g, r, axis=1, keepdims=False)
        k_band = lax.dynamic_slice_in_dim(k_g, rs, kr, axis=1)
        v_band = lax.dynamic_slice_in_dim(v_g, rs, kr, axis=1)
        k_win = k_band[:, :, col_idx]
        v_win = v_band[:, :, col_idx]
        s = jnp.einsum('bchd,bkcwhd->bhckw', q_r, k_win).astype(jnp.float32) * scale
        row_off = rs + jnp.arange(kr) - r + (NA_ROWS - 1)
        bias = rpb_f[:, row_off[None, :, None], col_off[:, None, :]]
        s = (s + bias[None]).reshape(B, N_HEADS_B, GRID_W, kr * NA_COLS)
        p = jax.nn.softmax(s, axis=-1).reshape(B, N_HEADS_B, GRID_W, kr, NA_COLS).astype(v.dtype)
        return jnp.einsum('bhckw,bkcwhd->bchd', p, v_win)

    out = lax.map(row_block, jnp.arange(rows))
    return out.transpose(1, 0, 2, 3, 4).reshape(B, S, N_HEADS_B * HEAD_DIM)


def peer(h, w_query, sub_keys, u_experts, v_experts):
    B, S, D = h.shape
    tokens = h.reshape(B * S // PEER_CHUNK, PEER_CHUNK, D)

    def chunk(xc):
        qh = (xc @ w_query).reshape(PEER_CHUNK, PEER_HEADS, PEER_QDIM)
        s1 = jnp.einsum('thd,hnd->thn', qh[..., :PEER_HALF], sub_keys[:, 0]).astype(jnp.float32)
        s2 = jnp.einsum('thd,hnd->thn', qh[..., PEER_HALF:], sub_keys[:, 1]).astype(jnp.float32)
        v1, i1 = lax.top_k(s1, PEER_TOPK)
        v2, i2 = lax.top_k(s2, PEER_TOPK)
        cand = (v1[..., :, None] + v2[..., None, :]).reshape(PEER_CHUNK, PEER_HEADS, PEER_TOPK * PEER_TOPK)
        vs, ci = lax.top_k(cand, PEER_TOPK)
        e1 = jnp.take_along_axis(i1, ci // PEER_TOPK, axis=-1)
        e2 = jnp.take_along_axis(i2, ci % PEER_TOPK, axis=-1)
        idx = e1 * PEER_KEYS + e2
        g = jax.nn.softmax(vs, axis=-1)
        u_sel = u_experts[idx]
        v_sel = v_experts[idx]
        z = jnp.einsum('td,thkd->thk', xc, u_sel)
        a = (jax.nn.gelu(z.astype(jnp.float32)) * g).astype(xc.dtype)
        return jnp.einsum('thk,thkd->td', a, v_sel)

    out = lax.map(chunk, tokens)
    return out.reshape(B, S, D)


def setup_inputs(seed: int = 0) -> dict:
    key = jax.random.key(seed)
    ks = jax.random.split(key, 20)
    f32 = jnp.float32
    D = D_MODEL
    nrm = lambda k, shape, s: jax.random.normal(k, shape, f32) * s
    return {
        "x": nrm(ks[0], (BATCH, SEQ, D), 1.0),
        "c": nrm(ks[1], (BATCH, D), 1.0),
        "w_ada": nrm(ks[2], (DEPTH, D, 6 * D), 0.5 * D ** -0.5),
        "b_ada": nrm(ks[3], (DEPTH, 6 * D), 0.02),
        "norm1_g": 1.0 + nrm(ks[4], (DEPTH, D), 0.02),
        "w_in": nrm(ks[5], (DEPTH, D, D_IN), D ** -0.5),
        "sink_a": nrm(ks[6], (DEPTH, N_HEADS_A), 0.5),
        "t5_table": nrm(ks[7], (T5_BUCKETS, N_HEADS_A), 0.3),
        "rpb_b": nrm(ks[8], (DEPTH, N_HEADS_B, 2 * NA_ROWS - 1, 2 * NA_COLS - 1), 0.3),
        "out_norm_a": 1.0 + nrm(ks[9], (DEPTH, W_QA), 0.02),
        "out_norm_b": 1.0 + nrm(ks[10], (DEPTH, W_B), 0.02),
        "w_out": nrm(ks[11], (DEPTH, D_MIX, D), D_MIX ** -0.5),
        "norm2_g": 1.0 + nrm(ks[12], (DEPTH, D), 0.02),
        "w_query": nrm(ks[13], (DEPTH, D, PEER_HEADS * PEER_QDIM), D ** -0.5),
        "sub_keys": nrm(ks[14], (DEPTH, PEER_HEADS, 2, PEER_KEYS, PEER_HALF), PEER_HALF ** -0.5),
        "u_experts": nrm(ks[15], (DEPTH, N_EXPERTS, D), D ** -0.5),
        "v_experts": nrm(ks[16], (DEPTH, N_EXPERTS, D), 1.0),
        "final_g": 1.0 + nrm(ks[17], (D,), 0.02),
    }


def reference(x, c, w_ada, b_ada, norm1_g, w_in, sink_a, t5_table, rpb_b, out_norm_a, out_norm_b,
              w_out, norm2_g, w_query, sub_keys, u_experts, v_experts, final_g):
    B, S, D = x.shape
    c_act = jax.nn.silu(c)
    for layer in range(DEPTH):
        ada = c_act @ w_ada[layer] + b_ada[layer]
        shift1, scale1, gate1, shift2, scale2, gate2 = jnp.split(ada, 6, axis=-1)

        h = modulate(rms_norm(x, norm1_g[layer]), shift1, scale1)
        proj = h @ w_in[layer]
        qa, ka, va, qb, kb, vb = jnp.split(proj, IN_SPLITS, axis=-1)
        o_a = windowed_gqa(qa.reshape(B, S, N_HEADS_A, HEAD_DIM),
                           ka.reshape(B, S, N_KV_A, HEAD_DIM),
                           va.reshape(B, S, N_KV_A, HEAD_DIM),
                           sink_a[layer], t5_table)
        o_b = neighbourhood_attention(qb.reshape(B, S, N_HEADS_B, HEAD_DIM),
                                      kb.reshape(B, S, N_HEADS_B, HEAD_DIM),
                                      vb.reshape(B, S, N_HEADS_B, HEAD_DIM),
                                      rpb_b[layer])
        mixed = jnp.concatenate([rms_norm(o_a, out_norm_a[layer]),
                                 rms_norm(o_b, out_norm_b[layer])], axis=-1)
        x = x + gate1[:, None, :] * (mixed @ w_out[layer])

        h2 = modulate(rms_norm(x, norm2_g[layer]), shift2, scale2)
        x = x + gate2[:, None, :] * peer(h2, w_query[layer], sub_keys[layer],
                                          u_experts[layer], v_experts[layer])
    return rms_norm(x, final_g)
```

```cpp
#include <hip/hip_runtime.h>
#include <cstdio>
#include <cstdint>

#define GAS __attribute__((address_space(1)))
#define LAS __attribute__((address_space(3)))
typedef unsigned short bf16;
typedef unsigned v4u __attribute__((ext_vector_type(4)));
typedef unsigned v2u __attribute__((ext_vector_type(2)));
typedef float f32x4 __attribute__((ext_vector_type(4)));
typedef float f32x16 __attribute__((ext_vector_type(16)));
typedef short bf16x8 __attribute__((ext_vector_type(8)));
typedef __bf16 bf16x2v __attribute__((ext_vector_type(2)));

#define MFMA32(a, b, c) __builtin_amdgcn_mfma_f32_32x32x16_bf16((a), (b), (c), 0, 0, 0)
#define LDS_WAIT() asm volatile("s_waitcnt lgkmcnt(0)" ::: "memory")

constexpr int NB = 4, S = 8192, D = 1024, M = NB * S;
constexpr int N1A = 1792;
constexpr int NVT = 768;
constexpr int NQ = 2048;
constexpr int NEXP = 16384;
constexpr float EPS = 1e-6f;
constexpr int NWAVES = 8, NTHREADS = 512;

constexpr size_t MiB = 1u << 20;
constexpr size_t WS_CTL = 0, CTL_ZERO_BYTES = 64 * 1024;
constexpr size_t WS_ADA = 1 * MiB;
constexpr size_t WS_WO = 2 * MiB;
constexpr size_t WS_WQ = 4 * MiB;
constexpr size_t WS_SK = 8 * MiB;
constexpr size_t WS_WBIG = 10 * MiB;
constexpr size_t WS_W1A = WS_WBIG, WS_H = WS_WBIG + (size_t)N1A * D * 2, WS_WVT = WS_H + (size_t)M * D * 2;
constexpr size_t WS_SU = 1 * MiB + 256 * 1024, WS_SV = 1 * MiB + 512 * 1024, WS_SX = 1 * MiB + 768 * 1024;
constexpr size_t WS_U8 = 80 * MiB, WS_V8 = 96 * MiB;
constexpr size_t WS_X8 = 112 * MiB;
constexpr size_t WS_PROJ = 144 * MiB;
constexpr size_t WS_VT = 256 * MiB;
constexpr size_t WS_QP = 144 * MiB;
constexpr size_t WS_MIX = 306 * MiB;
constexpr size_t WS_IDX = 372 * MiB;
constexpr size_t WS_G = 388 * MiB;
constexpr size_t WS_X1 = 416 * MiB;
constexpr size_t WS_END = 480 * MiB;
static_assert(WS_VT + (size_t)NVT * M * 2 <= WS_MIX, "ws map");
static_assert(WS_WVT + (size_t)NVT * D * 2 <= WS_U8 && WS_X8 + (size_t)M * D <= WS_PROJ, "ws map");
static_assert(WS_QP + (size_t)M * NQ * 2 <= WS_MIX, "ws map");
constexpr int CW_BAR = 4096;
constexpr int CW_ADA = 12288;

static_assert((12288 + 64) * 4 <= (int)CTL_ZERO_BYTES && (4096 + 3456) * 4 <= (int)CTL_ZERO_BYTES, "control words inside the per-call memset");
constexpr int LDS_BYTES = 147456;
constexpr int MISC_OFF = 131072 + 320;

typedef float f32x2v __attribute__((ext_vector_type(2)));
__device__ __forceinline__ unsigned pk2(float lo, float hi) { f32x2v v; v.x = lo; v.y = hi; return __builtin_bit_cast(unsigned, __builtin_convertvector(v, bf16x2v)); }
__device__ __forceinline__ float bflo(unsigned w) { return __builtin_bit_cast(float, w << 16); }
__device__ __forceinline__ float bfhi(unsigned w) { return __builtin_bit_cast(float, w & 0xffff0000u); }
constexpr int DPP_XOR1 = 0xB1, DPP_XOR2 = 0x4E, DPP_ROR4 = 0x124, DPP_ROR8 = 0x128;
template <int CTRL> __device__ __forceinline__ float dppf(float x) { return __builtin_bit_cast(float, __builtin_amdgcn_mov_dpp(__builtin_bit_cast(int, x), CTRL, 0xf, 0xf, true)); }
template <int CTRL> __device__ __forceinline__ int dppi(int x) { return __builtin_amdgcn_mov_dpp(x, CTRL, 0xf, 0xf, true); }
__device__ __forceinline__ void halves(float x, float& lo, float& hi) {
    auto t = __builtin_amdgcn_permlane32_swap(__builtin_bit_cast(unsigned, x), __builtin_bit_cast(unsigned, x), false, false);
    const unsigned a = t[0], b = t[1];
    lo = __builtin_bit_cast(float, a); hi = __builtin_bit_cast(float, b);
}
__device__ __forceinline__ float xhalf_max(float x) { float a, b; halves(x, a, b); return fmaxf(a, b); }
__device__ __forceinline__ float xhalf_sum(float x) { float a, b; halves(x, a, b); return a + b; }
__device__ __forceinline__ float wave_sum(float v) {
    v += dppf<DPP_XOR1>(v); v += dppf<DPP_XOR2>(v); v += dppf<DPP_ROR4>(v); v += dppf<DPP_ROR8>(v);
    auto s = __builtin_amdgcn_permlane16_swap(__builtin_bit_cast(unsigned, v), __builtin_bit_cast(unsigned, v), false, false);
    const unsigned s0 = s[0], s1 = s[1];
    v = __builtin_bit_cast(float, s0) + __builtin_bit_cast(float, s1);
    return xhalf_sum(v);
}
__device__ __forceinline__ float wave_max(float v) {
    v = fmaxf(v, dppf<DPP_XOR1>(v)); v = fmaxf(v, dppf<DPP_XOR2>(v)); v = fmaxf(v, dppf<DPP_ROR4>(v)); v = fmaxf(v, dppf<DPP_ROR8>(v));
    auto s = __builtin_amdgcn_permlane16_swap(__builtin_bit_cast(unsigned, v), __builtin_bit_cast(unsigned, v), false, false);
    const unsigned s0 = s[0], s1 = s[1];
    v = fmaxf(__builtin_bit_cast(float, s0), __builtin_bit_cast(float, s1));
    return xhalf_max(v);
}
__device__ __forceinline__ unsigned q8(float v, float inv, int bias) {
    float q = rintf(v * inv); q = fminf(fmaxf(q, -127.f), 127.f);
    return (unsigned)((int)q + bias) & 0xffu;
}
__device__ __forceinline__ unsigned q8x4(const f32x4& v, float inv, int bias) { return q8(v.x, inv, bias) | (q8(v.y, inv, bias) << 8) | (q8(v.z, inv, bias) << 16) | (q8(v.w, inv, bias) << 24); }
__device__ __forceinline__ int crow(int i, int h) { return (i & 3) + 8 * (i >> 2) + 4 * h; }

#define XB_TMO      128
#define XB_XCNT(j)  (256  + 64 * (j))
#define XB_XSUB(j)  (1280 + 64 * (j))
#define XB_XGEN(j)  (2304 + 64 * (j))
#define XB_TOP      3328
#define XB_TOPGEN   3392
#define XCD_BAR_WORDS 3456
#define XB_SPIN_CAP (1u << 18)

__device__ __forceinline__ unsigned xb_ld(unsigned* p)              { return __hip_atomic_load(p, __ATOMIC_RELAXED, __HIP_MEMORY_SCOPE_AGENT); }
__device__ __forceinline__ unsigned xb_add(unsigned* p, unsigned v) { return __hip_atomic_fetch_add(p, v, __ATOMIC_RELAXED, __HIP_MEMORY_SCOPE_AGENT); }
__device__ __forceinline__ unsigned xb_xcc_id() { return (unsigned)__builtin_amdgcn_s_getreg((3 << 11) | 20) & 0xFu; }
#define XB_SPIN(cond, bar) do { unsigned _sp = 0; while (cond) { __builtin_amdgcn_s_sleep(1); \
    if ((++_sp & 255u) == 0u) { if (xb_ld(&(bar)[XB_TMO])) break; if (_sp > XB_SPIN_CAP) { atomicAdd(&(bar)[XB_TMO], 1u); break; } } } } while (0)

struct XcdBarrier {
    unsigned* bar; unsigned x;
    volatile LAS unsigned* st;
};
__device__ __forceinline__ XcdBarrier xcd_barrier_post(unsigned* bar, volatile LAS unsigned* st) {
    XcdBarrier b; b.bar = bar; b.x = xb_xcc_id(); b.st = st;
    if (threadIdx.x == 0) (void)xb_add(&bar[XB_XCNT(b.x)], 1u);
    return b;
}
__device__ __forceinline__ void xcd_barrier_complete(unsigned* bar, unsigned x, unsigned& nloc, unsigned& nx) {
    const unsigned G = gridDim.x * gridDim.y * gridDim.z;
    unsigned sum, cnt, mine, sp = 0u;
    for (;;) {
        sum = 0u; cnt = 0u; mine = 0u;
#pragma unroll
        for (unsigned j = 0; j < 16; ++j) { const unsigned c = xb_ld(&bar[XB_XCNT(j)]); sum += c; cnt += (c > 0u) ? 1u : 0u; mine = (j == x) ? c : mine; }
        if (sum == G) break;
        __builtin_amdgcn_s_sleep(1);
        if ((++sp & 255u) == 0u) { if (xb_ld(&bar[XB_TMO])) break; if (sp > XB_SPIN_CAP) { atomicAdd(&bar[XB_TMO], 1u); break; } }
    }
    nloc = mine > 0u ? mine : 1u; nx = cnt > 0u ? cnt : 1u;
}
__device__ __forceinline__ void xcd_barrier(const XcdBarrier& b) {
    asm volatile("s_waitcnt vmcnt(0)" ::: "memory");
    __syncthreads();
    if (threadIdx.x == 0) {
        unsigned* bar = b.bar;
        __builtin_amdgcn_s_waitcnt(0);
        unsigned nloc = b.st[0], nx = b.st[1];
        if (nloc == 0u) { xcd_barrier_complete(bar, b.x, nloc, nx); b.st[0] = nloc; b.st[1] = nx; }
        const unsigned old = xb_add(&bar[XB_XSUB(b.x)], 1u);
        const unsigned gen = old / nloc;
        if (old + 1u == (gen + 1u) * nloc) {
            __builtin_amdgcn_fence(__ATOMIC_RELEASE, "agent");
            asm volatile("s_waitcnt vmcnt(0)" ::: "memory");
            const unsigned og = xb_add(&bar[XB_TOP], 1u);
            const unsigned tg = og / nx;
            if (og + 1u == (tg + 1u) * nx) xb_add(&bar[XB_TOPGEN], 1u);
            else XB_SPIN(xb_ld(&bar[XB_TOPGEN]) == tg, bar);
            __builtin_amdgcn_fence(__ATOMIC_ACQUIRE, "agent");
            xb_add(&bar[XB_XGEN(b.x)], 1u);
            asm volatile("s_waitcnt vmcnt(0)" ::: "memory");
        } else {
            XB_SPIN(xb_ld(&bar[XB_XGEN(b.x)]) == gen, bar);
            __builtin_amdgcn_fence(__ATOMIC_ACQUIRE, "agent");
            asm volatile("s_waitcnt vmcnt(0)" ::: "memory");
        }
    }
    __syncthreads();
}

namespace pg8 {
#define PG8_LAS __attribute__((address_space(3)))
typedef unsigned short bf16_t;
typedef short bf16x8 __attribute__((ext_vector_type(8)));
typedef float f32x4 __attribute__((ext_vector_type(4)));
typedef unsigned u32x4 __attribute__((ext_vector_type(4)));
constexpr int BM = 256, BK = 64, HALF = 128, HTB = HALF * BK * 2  , STAGE_BYTES = 8 * HTB, NXCD = 8, WGM = 8;

__host__ __device__ __forceinline__ int lds_byte(int r, int c) { const int st = (r >> 4) * 2 + (c >> 5), rr = r & 15, cc = c & 31, ob = rr * 64 + cc * 2; return st * 1024 + (ob ^ (((ob >> 9) & 1) << 5)); }
__host__ __device__ __forceinline__ void stage_rc(int b, int& R, int& C) { const int st = b / 1024, sb = b % 1024, swz = sb ^ (((sb >> 9) & 1) << 5); R = (st >> 1) * 16 + swz / 64; C = (st & 1) * 32 + (swz % 64) / 2; }
__host__ __device__ __forceinline__ int perm32(int rho) { const int n = rho >> 4, i = rho & 15; return 8 * (i >> 2) + 4 * n + (i & 3); }

struct Unit { int pm, pn; };
struct Gemm { const bf16_t* A; const bf16_t* Bt; int M, N, K, lda, ldb; };

struct StaticOrder {
    int nM, nN, nwg, G, c;
    __host__ __device__ void init(int M, int N, int G_, int c_) { nM = M / BM; nN = N / BM; nwg = nM * nN; G = G_; c = c_; }
    __host__ __device__ bool next(int i, Unit& u) const {
        const long L = (long)i * G + c; if (L >= nwg) return false;
        int wgid = (int)L; { const int q = nwg / NXCD, r = nwg % NXCD, xcd = wgid % NXCD, off = wgid / NXCD; wgid = (xcd < r ? xcd * (q + 1) : r * (q + 1) + (xcd - r) * q) + off; }
        const int nig = WGM * nN, gid = wgid / nig, fm = gid * WGM, gsz = (nM - fm) < WGM ? (nM - fm) : WGM;
        u.pm = fm + ((wgid % nig) % gsz); u.pn = (wgid % nig) / gsz; return true;
    }
    __device__ __forceinline__ void a_ready(const Unit&) const {}
    __device__ __forceinline__ void done(const Unit&) const {}
};
struct Gemm1Order {
    StaticOrder a, b; int G, c;
    __host__ __device__ void init(int G_, int c_) { G = G_; c = c_; a.init(32768, 1792, G_, 0); b.init(768, 32768, G_, 0); }
    __host__ __device__ bool next(int i, Unit& u) const {
        const long L = (long)i * G + c;
        if (L < a.nwg) { StaticOrder t = a; t.G = 1; t.c = 0; return t.next((int)L, u); }
        if (L < a.nwg + b.nwg) { StaticOrder t = b; t.G = 1; t.c = 0; t.next((int)(L - a.nwg), u); u.pm += 128; u.pn += 7; return true; }
        return false;
    }
    __device__ __forceinline__ void a_ready(const Unit&) const {}
    __device__ __forceinline__ void done(const Unit&) const {}
};


__device__ __forceinline__ unsigned cvt_pk_bf16(float lo, float hi) { unsigned r; asm volatile("v_cvt_pk_bf16_f32 %0, %1, %2" : "=v"(r) : "v"(lo), "v"(hi)); return r; }
struct EpiQKFrag {
    static constexpr bool PERM = true, AFTER_DRAIN = false;
    bf16_t* O; int Mtok;
    __device__ __forceinline__ void operator()(const f32x4 (&acc)[2][2][4][2], const Unit& u, int wr, int wc, int fr, int fq) const {
        const int row0 = u.pm * BM + wr * 64 + fr, col0 = u.pn * BM + wc * 32 + 8 * fq;
#pragma unroll
        for (int ai = 0; ai < 2; ++ai)
#pragma unroll
            for (int m = 0; m < 4; ++m) { const int row = row0 + ai * HALF + m * 16;
#pragma unroll
                for (int bj = 0; bj < 2; ++bj) { const int c = col0 + bj * HALF, hb = c >> 6, d0 = c & 63;
                    const f32x4 v0 = acc[ai][bj][m][0], v1 = acc[ai][bj][m][1];
                    u32x4 w; w.x = cvt_pk_bf16(v0[0], v0[1]); w.y = cvt_pk_bf16(v0[2], v0[3]); w.z = cvt_pk_bf16(v1[0], v1[1]); w.w = cvt_pk_bf16(v1[2], v1[3]);
                    *(u32x4*)(O + (size_t)hb * Mtok * 64 + (size_t)(row >> 5) * 2048 + (d0 >> 3) * 256 + (row & 31) * 8) = w; } }
    }
};
struct EpiVTFrag {
    static constexpr bool PERM = true, AFTER_DRAIN = false;
    bf16_t* O; int Mtok;
    __device__ __forceinline__ void operator()(const f32x4 (&acc)[2][2][4][2], const Unit& u, int wr, int wc, int fr, int fq) const {
        typedef unsigned u32x2 __attribute__((ext_vector_type(2)));
        const int row0 = u.pm * BM + wr * 64 + fr, col0 = u.pn * BM + wc * 32 + 8 * fq;
#pragma unroll
        for (int ai = 0; ai < 2; ++ai)
#pragma unroll
            for (int m = 0; m < 4; ++m) { const int vrow = row0 + ai * HALF + m * 16, vb = vrow >> 6, dt = (vrow >> 5) & 1, r = vrow & 31;
#pragma unroll
                for (int bj = 0; bj < 2; ++bj) { const int t0 = col0 + bj * HALF, k0 = t0 & 31, sk = k0 >> 4, half = (k0 >> 3) & 1;
                    const f32x4 v0 = acc[ai][bj][m][0], v1 = acc[ai][bj][m][1];
                    bf16_t* base = O + (size_t)vb * Mtok * 64 + (size_t)(t0 >> 5) * 2048 + ((dt * 2 + sk) * 2) * 256 + r * 8 + 4 * half;
                    u32x2 lo, hi; lo.x = cvt_pk_bf16(v0[0], v0[1]); lo.y = cvt_pk_bf16(v0[2], v0[3]); hi.x = cvt_pk_bf16(v1[0], v1[1]); hi.y = cvt_pk_bf16(v1[2], v1[3]);
                    *(u32x2*)(base) = lo;
                    *(u32x2*)(base + 256) = hi; } }
    }
};
struct EpiGemm1 {
    static constexpr bool PERM = true, AFTER_DRAIN = false;
    EpiQKFrag qk; EpiVTFrag vt;
    __device__ __forceinline__ void operator()(const f32x4 (&acc)[2][2][4][2], const Unit& u, int wr, int wc, int fr, int fq) const {
        if (u.pm < 128) qk(acc, u, wr, wc, fr, fq);
        else { Unit v; v.pm = u.pm - 128; v.pn = u.pn - 7; vt(acc, v, wr, wc, fr, fq); }
    }
};
struct EpiResGate {
    static constexpr bool PERM = true, AFTER_DRAIN = false;
    const float* x; const float* ada; bf16_t* out;
    __device__ __forceinline__ void operator()(const f32x4 (&acc)[2][2][4][2], const Unit& u, int wr, int wc, int fr, int fq) const {
        const int row0 = u.pm * BM + wr * 64 + fr, col0 = u.pn * BM + wc * 32 + 8 * fq;
        const float* gate = ada + (size_t)((u.pm * BM) >> 13) * 6144 + 2048;
        f32x4 gv[2][2];
#pragma unroll
        for (int bj = 0; bj < 2; ++bj)
#pragma unroll
            for (int n = 0; n < 2; ++n) gv[bj][n] = *(const f32x4*)(gate + col0 + bj * HALF + 4 * n);
#pragma unroll
        for (int ai = 0; ai < 2; ++ai)
#pragma unroll
            for (int m = 0; m < 4; ++m) { const size_t off = (size_t)(row0 + ai * HALF + m * 16) * 1024 + col0;
#pragma unroll
                for (int bj = 0; bj < 2; ++bj) {
                    const f32x4 x0 = *(const f32x4*)(x + off + bj * HALF), x1 = *(const f32x4*)(x + off + bj * HALF + 4);
                    const f32x4 v0 = x0 + gv[bj][0] * acc[ai][bj][m][0], v1 = x1 + gv[bj][1] * acc[ai][bj][m][1];
                    u32x4 w; w.x = cvt_pk_bf16(v0[0], v0[1]); w.y = cvt_pk_bf16(v0[2], v0[3]); w.z = cvt_pk_bf16(v1[0], v1[1]); w.w = cvt_pk_bf16(v1[2], v1[3]);
                    *(u32x4*)(out + off + bj * HALF) = w; } }
    }
};

template <class Epi, class Sched, bool ALIGN_EPI = false, bool SP2 = false>
__device__ __forceinline__ void gemm_phase(PG8_LAS unsigned char* lds, const Gemm g, const Sched& S, const Epi& E) {
    int tid = threadIdx.x; asm volatile("" : "+v"(tid));
    const int wid = __builtin_amdgcn_readfirstlane(tid >> 6), lane = tid & 63, wr = wid >> 2, wc = wid & 3, fr = lane & 15, fq = lane >> 4;
    const int K = g.K, nt = K / BK;
    unsigned voffA[2], voffB[2];
#pragma unroll
    for (int i = 0; i < 2; ++i) { int R, C; stage_rc(tid * 16 + i * 8192, R, C); const int Rb = Epi::PERM ? ((R & ~31) + perm32(R & 31)) : R;
        voffA[i] = (unsigned)(R * g.lda + C) * 2u; voffB[i] = (unsigned)(Rb * g.ldb + C) * 2u; }
    const size_t kstep = (size_t)(BK * 2);
    const size_t hstepA = (size_t)HALF * g.lda * 2, hstepB = (size_t)HALF * g.ldb * 2;
    const size_t tstepA = 2 * hstepA, tstepB = 2 * hstepB;
    const unsigned ldsw = (unsigned)wid * 1024u;
    const int aoff = lds_byte(wr * 64 + fr, fq * 8), boff = lds_byte(wc * 32 + fr, fq * 8);
#define PG8_SA(b, h) (((b) * 2 + (h)) * HTB)
#define PG8_SB(b, h) ((4 + (b) * 2 + (h)) * HTB)
#define PG8_STAGE(bufoff, gbase, voff) do { _Pragma("unroll") for (int _i = 0; _i < 2; ++_i) \
        __builtin_amdgcn_global_load_lds((const unsigned*)((const char*)(gbase) + (voff)[_i]), (PG8_LAS unsigned*)(lds + (bufoff) + ldsw + _i * 8192), 16, 0, 0); } while (0)
#define PG8_LDA(dst, b, h) do { _Pragma("unroll") for (int m = 0; m < 4; ++m) _Pragma("unroll") for (int k = 0; k < 2; ++k) dst[m][k] = *(const PG8_LAS bf16x8*)(lds + PG8_SA(b, h) + aoff + m * 2048 + k * 1024); } while (0)
#define PG8_LDB(dst, b, h) do { _Pragma("unroll") for (int n = 0; n < 2; ++n) _Pragma("unroll") for (int k = 0; k < 2; ++k) dst[n][k] = *(const PG8_LAS bf16x8*)(lds + PG8_SB(b, h) + boff + n * 2048 + k * 1024); } while (0)
#define PG8_MMA(ai, bj, At, Bt) do { __builtin_amdgcn_s_setprio(1); _Pragma("unroll") for (int m = 0; m < 4; ++m) _Pragma("unroll") for (int n = 0; n < 2; ++n) _Pragma("unroll") for (int k = 0; k < 2; ++k) \
        acc[ai][bj][m][n] = __builtin_amdgcn_mfma_f32_16x16x32_bf16(Bt[n][k], At[m][k], acc[ai][bj][m][n], 0, 0, 0); __builtin_amdgcn_s_setprio(0); } while (0)
#define PG8_WAIT_V(n) asm volatile("s_waitcnt vmcnt(" #n ")" ::: "memory")
#define PG8_WAIT_L(n) asm volatile("s_waitcnt lgkmcnt(" #n ")" ::: "memory")
#define PG8_BAR __builtin_amdgcn_s_barrier()
#define PG8_SCHED __builtin_amdgcn_sched_barrier(0)
    Unit cur, nxt; int ui = 0;
    if (!S.next(0, cur)) return;
    f32x4 acc[2][2][4][2];
#pragma unroll
    for (int a = 0; a < 2; ++a)
#pragma unroll
        for (int b = 0; b < 2; ++b)
#pragma unroll
            for (int m = 0; m < 4; ++m)
#pragma unroll
                for (int n = 0; n < 2; ++n) acc[a][b][m][n] = (f32x4){0.f, 0.f, 0.f, 0.f};
    bf16x8 At[4][2], B0[2][2], B1[2][2];
    const char* cA = (const char*)g.A + (size_t)cur.pm * tstepA; const char* cB = (const char*)g.Bt + (size_t)cur.pn * tstepB;
    S.a_ready(cur);
    if constexpr (SP2) {
        PG8_STAGE(PG8_SB(0, 0), cB, voffB); PG8_STAGE(PG8_SB(0, 1), cB + hstepB, voffB); PG8_STAGE(PG8_SA(0, 0), cA, voffA); PG8_STAGE(PG8_SA(0, 1), cA + hstepA, voffA);
        if (wr == 1) PG8_BAR;
        PG8_WAIT_V(2); PG8_BAR;
        PG8_STAGE(PG8_SB(1, 0), cB + kstep, voffB); PG8_STAGE(PG8_SA(1, 0), cA + kstep, voffA); PG8_STAGE(PG8_SB(1, 1), cB + hstepB + kstep, voffB);
        PG8_WAIT_V(6); PG8_BAR;
    } else {
        PG8_STAGE(PG8_SB(0, 0), cB, voffB); PG8_STAGE(PG8_SA(0, 0), cA, voffA); PG8_STAGE(PG8_SB(0, 1), cB + hstepB, voffB); PG8_STAGE(PG8_SA(0, 1), cA + hstepA, voffA);
        if (wr == 1) PG8_BAR;
        PG8_WAIT_V(4); PG8_BAR;
        PG8_STAGE(PG8_SB(1, 0), cB + kstep, voffB); PG8_STAGE(PG8_SA(1, 0), cA + kstep, voffA); PG8_STAGE(PG8_SB(1, 1), cB + hstepB + kstep, voffB);
        PG8_WAIT_V(6); PG8_BAR;
    }
    for (;;) {
        const bool has_next = S.next(ui + 1, nxt);
        const char* nA = has_next ? (const char*)g.A + (size_t)nxt.pm * tstepA : cA; const char* nB = has_next ? (const char*)g.Bt + (size_t)nxt.pn * tstepB : cB;
        for (int t = 0; t < nt; t += 2) {
            const bool last = (t == nt - 2);
            const char* a1 = cA + (size_t)(t + 1) * kstep;
            const char* a2 = last ? nA : cA + (size_t)(t + 2) * kstep; const char* b2 = last ? nB : cB + (size_t)(t + 2) * kstep;
            const char* a3 = a2 + kstep; const char* b3 = b2 + kstep;
            if (last && has_next) S.a_ready(nxt);
            if constexpr (SP2) {
            PG8_LDB(B0, 0, 0); PG8_LDB(B1, 0, 1); PG8_SCHED; PG8_LDA(At, 0, 0); PG8_STAGE(PG8_SA(1, 1), a1 + hstepA, voffA);
            PG8_WAIT_V(8); PG8_WAIT_L(0); PG8_BAR; PG8_MMA(0, 0, At, B0); PG8_MMA(0, 1, At, B1); PG8_BAR; PG8_SCHED;
            PG8_LDA(At, 0, 1); PG8_STAGE(PG8_SB(0, 0), b2, voffB); PG8_STAGE(PG8_SB(0, 1), b2 + hstepB, voffB); PG8_STAGE(PG8_SA(0, 0), a2, voffA);
            PG8_WAIT_V(8); PG8_WAIT_L(0); PG8_BAR; PG8_MMA(1, 0, At, B0); PG8_MMA(1, 1, At, B1); PG8_BAR; PG8_SCHED;
            PG8_LDB(B0, 1, 0); PG8_LDB(B1, 1, 1); PG8_SCHED; PG8_LDA(At, 1, 0); PG8_STAGE(PG8_SA(0, 1), a2 + hstepA, voffA);
            PG8_WAIT_V(8); PG8_WAIT_L(0); PG8_BAR; PG8_MMA(0, 0, At, B0); PG8_MMA(0, 1, At, B1); PG8_BAR; PG8_SCHED;
            PG8_LDA(At, 1, 1); PG8_STAGE(PG8_SB(1, 0), b3, voffB); PG8_STAGE(PG8_SB(1, 1), b3 + hstepB, voffB); PG8_STAGE(PG8_SA(1, 0), a3, voffA);
            PG8_WAIT_V(8); PG8_WAIT_L(0); PG8_BAR; PG8_MMA(1, 0, At, B0); PG8_MMA(1, 1, At, B1); PG8_BAR; PG8_SCHED;
            } else {
            PG8_LDB(B0, 0, 0); PG8_SCHED; PG8_LDA(At, 0, 0); PG8_STAGE(PG8_SA(1, 1), a1 + hstepA, voffA);
            PG8_WAIT_L(8); PG8_BAR; PG8_WAIT_L(0); PG8_MMA(0, 0, At, B0); PG8_BAR; PG8_SCHED;
            PG8_LDB(B1, 0, 1); PG8_STAGE(PG8_SB(0, 0), b2, voffB);
            PG8_BAR; PG8_WAIT_L(0); PG8_MMA(0, 1, At, B1); PG8_BAR;
            PG8_LDA(At, 0, 1); PG8_STAGE(PG8_SA(0, 0), a2, voffA);
            PG8_BAR; PG8_WAIT_L(0); PG8_MMA(1, 0, At, B0); PG8_BAR; PG8_SCHED;
            PG8_STAGE(PG8_SB(0, 1), b2 + hstepB, voffB);
            PG8_WAIT_V(6); PG8_BAR; PG8_MMA(1, 1, At, B1); PG8_BAR;
            PG8_LDB(B0, 1, 0); PG8_SCHED; PG8_LDA(At, 1, 0); PG8_STAGE(PG8_SA(0, 1), a2 + hstepA, voffA);
            PG8_WAIT_L(8); PG8_BAR; PG8_WAIT_L(0); PG8_MMA(0, 0, At, B0); PG8_BAR; PG8_SCHED;
            PG8_LDB(B1, 1, 1); PG8_STAGE(PG8_SB(1, 0), b3, voffB);
            PG8_BAR; PG8_WAIT_L(0); PG8_MMA(0, 1, At, B1); PG8_BAR;
            PG8_LDA(At, 1, 1); PG8_STAGE(PG8_SA(1, 0), a3, voffA);
            PG8_BAR; PG8_WAIT_L(0); PG8_MMA(1, 0, At, B0); PG8_BAR; PG8_SCHED;
            PG8_STAGE(PG8_SB(1, 1), b3 + hstepB, voffB);
            PG8_WAIT_V(6); PG8_BAR; PG8_MMA(1, 1, At, B1); PG8_BAR;
            }
        }
        if constexpr (ALIGN_EPI) { if (wr == 0) PG8_BAR; }
        if constexpr (!Epi::AFTER_DRAIN) { E(acc, cur, wr, wc, fr, fq); S.done(cur); }
        if (!has_next) break;
#pragma unroll
        for (int a = 0; a < 2; ++a)
#pragma unroll
            for (int b = 0; b < 2; ++b)
#pragma unroll
                for (int m = 0; m < 4; ++m)
#pragma unroll
                    for (int n = 0; n < 2; ++n) acc[a][b][m][n] = (f32x4){0.f, 0.f, 0.f, 0.f};
        cur = nxt; cA = nA; cB = nB; ++ui;
        if constexpr (ALIGN_EPI) { if (wr == 1) PG8_BAR; }
    }
    PG8_WAIT_V(0);
    if constexpr (!ALIGN_EPI) { if (wr == 0) PG8_BAR; }
    PG8_BAR;
    if constexpr (Epi::AFTER_DRAIN) { E.fused(acc, cur, wr, wc, fr, fq, lds, wid, lane); S.done(cur); }
#undef PG8_SA
#undef PG8_SB
#undef PG8_STAGE
#undef PG8_LDA
#undef PG8_LDB
#undef PG8_MMA
#undef PG8_WAIT_V
#undef PG8_WAIT_L
#undef PG8_BAR
#undef PG8_SCHED
}
}

struct Args { const float* in[18]; float* out; unsigned char* ws; };
struct Frame {
    LAS unsigned char* lds;
    int tid, lane, wave, G, bx, gw, ngw;
    const float *x, *c, *w_ada, *b_ada, *g1, *w_in, *sink, *t5, *rpb, *gna, *gnb, *w_out, *g2, *w_query, *sub_keys, *uexp, *vexp, *gfin;
    float* out; float* ada;
    bf16 *WO, *WQ, *SK, *W1A, *H, *WVT, *PROJ, *VT, *QP, *MIX;
    unsigned char *U8, *V8, *X8; float *SU, *SV, *SX; unsigned* ctl; volatile LAS unsigned* MISC; bf16* X1;
    int* IDX; float* GT;
};

__device__ __forceinline__ void p0_transpose_item(const float* W, int N, bf16* WT, int K, int k0, int n0, int dst_row0, float scale, LAS float* scr, int lane) {
#pragma unroll 8
    for (int i = 0; i < 32; ++i) { const int kk = 2 * i + (lane >> 5); scr[kk * 33 + (lane & 31)] = W[(size_t)(k0 + kk) * N + n0 + (lane & 31)] * scale; }
    LDS_WAIT(); asm volatile("" ::: "memory");
    const int c = lane & 7;
#pragma unroll
    for (int j = 0; j < 4; ++j) { const int n = (lane >> 3) + 8 * j; const LAS float* s = scr + (8 * c) * 33 + n;
        v4u o; o.x = pk2(s[0 * 33], s[1 * 33]); o.y = pk2(s[2 * 33], s[3 * 33]); o.z = pk2(s[4 * 33], s[5 * 33]); o.w = pk2(s[6 * 33], s[7 * 33]);
        *(v4u*)(WT + (size_t)(dst_row0 + n) * K + k0 + 8 * c) = o; }
    LDS_WAIT(); asm volatile("" ::: "memory");
}

__device__ __forceinline__ void p0_prologue(Frame& F) {
    {
        LAS float* sc = (LAS float*)F.lds;
        LAS float* red = (LAS float*)(F.lds + 16384);
        for (int i = F.tid; i < 4096; i += NTHREADS) { const float cv = F.c[i]; sc[i] = cv / (1.0f + __expf(-cv)); }
        __syncthreads();
        for (int item = F.bx; item < 96; item += F.G) {
            const int j = item * 64 + F.lane;
            float a0 = 0.f, a1 = 0.f, a2 = 0.f, a3 = 0.f;
            const int i0 = F.wave * 128;
#pragma unroll 4
            for (int i = i0; i < i0 + 128; ++i) {
                const float w = F.w_ada[(size_t)i * 6144 + j];
                a0 += sc[i] * w; a1 += sc[1024 + i] * w; a2 += sc[2048 + i] * w; a3 += sc[3072 + i] * w;
            }
            red[(F.wave * 4 + 0) * 64 + F.lane] = a0; red[(F.wave * 4 + 1) * 64 + F.lane] = a1;
            red[(F.wave * 4 + 2) * 64 + F.lane] = a2; red[(F.wave * 4 + 3) * 64 + F.lane] = a3;
            __syncthreads();
            if (F.wave < 4) {
                float s = F.b_ada[j];
#pragma unroll
                for (int w = 0; w < 8; ++w) s += red[(w * 4 + F.wave) * 64 + F.lane];
                F.ada[F.wave * 6144 + j] = s;
            }
            if (item < 32) {
                asm volatile("s_waitcnt vmcnt(0)" ::: "memory");
                __syncthreads();
                if (F.tid == 0) { __builtin_amdgcn_fence(__ATOMIC_RELEASE, "agent"); asm volatile("s_waitcnt vmcnt(0)" ::: "memory");
                                  __hip_atomic_fetch_add(F.ctl + CW_ADA, 1u, __ATOMIC_RELAXED, __HIP_MEMORY_SCOPE_AGENT); }
            }
            __syncthreads();
        }
        __syncthreads();
    }
    {
        LAS float* scr = (LAS float*)(F.lds + F.wave * 16384);
        constexpr int I_IN = 16 * 72, I_O = 16 * 32, I_Q = 16 * 64;
        for (int it = F.gw; it < I_IN + I_O + I_Q; it += F.ngw) {
            int r = it;
            if (r < I_IN) {
                const int kb = r / 72, nb = r % 72, n0 = 32 * nb;
                bf16* dst; int row0; float scale = 1.0f;
                if (n0 < 512) { dst = F.W1A; row0 = n0; scale = 0.125f * 1.4426950408889634f; }
                else if (n0 < 640) { dst = F.W1A; row0 = n0; }
                else if (n0 < 768) { dst = F.WVT; row0 = n0 - 640; }
                else if (n0 < 1280) { dst = F.W1A; row0 = n0 - 128; scale = 0.125f * 1.4426950408889634f; }
                else if (n0 < 1792) { dst = F.W1A; row0 = n0 - 128; }
                else { dst = F.WVT; row0 = 128 + (n0 - 1792); }
                p0_transpose_item(F.w_in, 2304, dst, D, 64 * kb, n0, row0, scale, scr, F.lane);
                continue;
            }
            r -= I_IN;
            if (r < I_O) { const int kb = r / 32, nb = r % 32; p0_transpose_item(F.w_out, 1024, F.WO, D, 64 * kb, 32 * nb, 32 * nb, 1.0f, scr, F.lane); continue; }
            r -= I_O;
            { const int kb = r / 64, nb = r % 64; p0_transpose_item(F.w_query, 2048, F.WQ, D, 64 * kb, 32 * nb, 32 * nb, 1.0f, scr, F.lane); }
        }
    }
    {
        const int gid = F.bx * NTHREADS + F.tid;
        if (gid < 16384) ((v4u*)(F.W1A + (size_t)1664 * D))[gid] = (v4u){0u, 0u, 0u, 0u};
        else if (gid < 32768) ((v4u*)(F.WVT + (size_t)640 * D))[gid - 16384] = (v4u){0u, 0u, 0u, 0u};
    }
    {
        for (int row0 = F.gw; row0 < 2 * NEXP; row0 += 4 * F.ngw) {
            f32x4 a[4][4];
#pragma unroll
            for (int u = 0; u < 4; ++u) { const int row = row0 + u * F.ngw; const bool isv = row >= NEXP; const int rr = isv ? row - NEXP : row;
                const f32x4* src = (const f32x4*)((isv ? F.vexp : F.uexp) + (size_t)rr * D) + 4 * F.lane;
                a[u][0] = src[0]; a[u][1] = src[1]; a[u][2] = src[2]; a[u][3] = src[3]; }
#pragma unroll
            for (int u = 0; u < 4; ++u) { const int row = row0 + u * F.ngw; const bool isv = row >= NEXP; const int rr = isv ? row - NEXP : row;
                float am = 0.f;
#pragma unroll
                for (int q = 0; q < 4; ++q) am = fmaxf(am, fmaxf(fmaxf(fabsf(a[u][q].x), fabsf(a[u][q].y)), fmaxf(fabsf(a[u][q].z), fabsf(a[u][q].w))));
                am = wave_max(am);
                const float inv = am > 0.f ? 127.0f / am : 0.f, scale = am * (1.0f / 127.0f);
                v4u o; o.x = q8x4(a[u][0], inv, 0); o.y = q8x4(a[u][1], inv, 0); o.z = q8x4(a[u][2], inv, 0); o.w = q8x4(a[u][3], inv, 0);
                *(v4u*)((isv ? F.V8 : F.U8) + ((size_t)(F.lane >> 3) * NEXP + rr) * 128 + (F.lane & 7) * 16) = o;
                if (F.lane == 0) (isv ? F.SV : F.SU)[rr] = scale; }
        }
        const size_t gid = (size_t)F.bx * NTHREADS + F.tid, gsz = (size_t)F.G * NTHREADS;
        for (size_t i = gid; i < 32768; i += gsz) {
            const int ln = (int)(i & 63), sk = (int)((i >> 6) & 7), nt = (int)((i >> 9) & 3), hh = (int)(i >> 11);
            const int n = 32 * nt + (ln & 31), d0 = 16 * sk + 8 * (ln >> 5);
            const f32x4* src = (const f32x4*)(F.sub_keys + ((size_t)hh * 128 + n) * 128 + d0);
            const f32x4 a = src[0], b = src[1];
            v4u o; o.x = pk2(a.x, a.y); o.y = pk2(a.z, a.w); o.z = pk2(b.x, b.y); o.w = pk2(b.z, b.w);
            ((v4u*)F.SK)[i] = o;
        }
    }
}

__device__ __forceinline__ void load_mod_vectors(f32x4 (&gs)[4], f32x4 (&sh)[4], const float* g, const float* shift, const float* scale, int lane) {
#pragma unroll
    for (int j = 0; j < 4; ++j) { const f32x4 gg = ((const f32x4*)g)[lane + 64 * j], sc = ((const f32x4*)scale)[lane + 64 * j]; gs[j] = gg * (sc + 1.0f); sh[j] = ((const f32x4*)shift)[lane + 64 * j]; }
}
__device__ __forceinline__ f32x4 load_row4(const float* row, int i4) { return ((const f32x4*)row)[i4]; }
__device__ __forceinline__ f32x4 load_row4(const bf16* row, int i4) { const v2u w = ((const v2u*)row)[i4]; return (f32x4){bflo(w.x), bfhi(w.x), bflo(w.y), bfhi(w.y)}; }
template <bool Q8, class TIN>
__device__ __forceinline__ void norm_mod_row(const TIN* xrow, bf16* orow, const f32x4 (&gs)[4], const f32x4 (&sh)[4], int lane, unsigned char* qrow = nullptr, float* qscale = nullptr) {
    f32x4 v[4]; float ss = 0.f;
#pragma unroll
    for (int j = 0; j < 4; ++j) { v[j] = load_row4(xrow, lane + 64 * j); ss += (v[j].x * v[j].x + v[j].y * v[j].y) + (v[j].z * v[j].z + v[j].w * v[j].w); }
    ss = wave_sum(ss);
    const float rstd = 1.0f / sqrtf(ss * (1.0f / 1024.0f) + EPS);
    unsigned long long* o8 = (unsigned long long*)orow + lane;
    float am = 0.f;
#pragma unroll
    for (int j = 0; j < 4; ++j) {
        const f32x4 y = v[j] * rstd * gs[j] + sh[j];
        o8[64 * j] = (unsigned long long)pk2(y.x, y.y) | ((unsigned long long)pk2(y.z, y.w) << 32);
        if (Q8) { v[j] = y; am = fmaxf(am, fmaxf(fmaxf(fabsf(y.x), fabsf(y.y)), fmaxf(fabsf(y.z), fabsf(y.w)))); }
    }
    if (Q8) {
        am = wave_max(am);
        const float inv = am > 0.f ? 127.0f / am : 0.f;
#pragma unroll
        for (int j = 0; j < 4; ++j) ((unsigned*)qrow)[lane + 64 * j] = q8x4(v[j], inv, 0);
        if (lane == 0) *qscale = am * (1.0f / 127.0f);
    }
}

__device__ __forceinline__ int t5_bucket_rel(int rel) {
    const int n = rel < 0 ? -rel : rel; int v;
    if (n < 8) v = n; else if (n < 12) v = 8; else if (n < 16) v = 9; else if (n < 23) v = 10; else if (n < 32) v = 11;
    else if (n < 46) v = 12; else if (n < 64) v = 13; else if (n < 91) v = 14; else v = 15;
    return (rel > 0 ? 16 : 0) + v;
}
__device__ __forceinline__ bf16x8 pack8(const float* p) {
    v4u w; w.x = pk2(p[0], p[1]); w.y = pk2(p[2], p[3]); w.z = pk2(p[4], p[5]); w.w = pk2(p[6], p[7]);
    return __builtin_bit_cast(bf16x8, w);
}
struct KFrag { bf16x8 k[4]; };
struct VFrag { v4u v[2][2]; };
__device__ __forceinline__ void load_k(KFrag& f, const bf16* blk) {
#pragma unroll
    for (int s = 0; s < 4; ++s) f.k[s] = *(const bf16x8*)(blk + 512 * s);
}
__device__ __forceinline__ void load_v(VFrag& f, const bf16* blk) {
#pragma unroll
    for (int dt = 0; dt < 2; ++dt)
#pragma unroll
        for (int s = 0; s < 2; ++s) f.v[dt][s] = *(const v4u*)(blk + (dt * 2 + s) * 512);
}
__device__ __forceinline__ f32x16 score_tile(const KFrag& kf, const bf16x8 (&qf)[4]) {
    f32x16 st;
#pragma unroll
    for (int i = 0; i < 16; ++i) st[i] = 0.f;
#pragma unroll
    for (int s = 0; s < 4; ++s) st = MFMA32(kf.k[s], qf[s], st);
    return st;
}
template <int RANGE>
__device__ __forceinline__ void attn_tile_update(const float (&sv)[16], float& m_run, float& l_run, f32x16 (&o)[2], const VFrag& f) {
    constexpr int LO = RANGE == 2 ? 12 : 0, HI = RANGE == 1 ? 4 : 16;
    float mx = sv[LO];
#pragma unroll
    for (int i = LO + 1; i < HI; ++i) mx = fmaxf(mx, sv[i]);
    mx = xhalf_max(mx);
    const float m_new = fmaxf(m_run, mx);
    const float alpha = __builtin_amdgcn_exp2f(m_run - m_new);
    float p[16]; float ls = 0.f;
#pragma unroll
    for (int i = 0; i < 16; ++i) { if (i >= LO && i < HI) { p[i] = __builtin_amdgcn_exp2f(sv[i] - m_new); ls += p[i]; } else p[i] = 0.f; }
    l_run = l_run * alpha + ls; m_run = m_new;
    if (__builtin_amdgcn_ballot_w64(alpha != 1.0f) != 0ull) {
#pragma unroll
        for (int dt = 0; dt < 2; ++dt)
#pragma unroll
            for (int i = 0; i < 16; ++i) o[dt][i] *= alpha;
    }
    if (RANGE != 2) { const bf16x8 pf0 = pack8(p);
#pragma unroll
        for (int dt = 0; dt < 2; ++dt) o[dt] = MFMA32(__builtin_bit_cast(bf16x8, f.v[dt][0]), pf0, o[dt]); }
    if (RANGE != 1) { const bf16x8 pf1 = pack8(p + 8);
#pragma unroll
        for (int dt = 0; dt < 2; ++dt) o[dt] = MFMA32(__builtin_bit_cast(bf16x8, f.v[dt][1]), pf1, o[dt]); }
}
__device__ __forceinline__ void attn_finalize(Frame& F, f32x16 (&o)[2], float l_run, LAS float* ssq, const float* gain  , bf16* orow  , int head, int r, int h) {
    const float lt = xhalf_sum(l_run);
    const float inv = 1.0f / lt;
    float sq = 0.f;
#pragma unroll
    for (int dt = 0; dt < 2; ++dt)
#pragma unroll
        for (int i = 0; i < 16; ++i) { o[dt][i] *= inv; sq += o[dt][i] * o[dt][i]; }
    sq = xhalf_sum(sq);
    if (h == 0) ssq[head * 32 + r] = sq;
    __syncthreads();
    float tot = 0.f;
#pragma unroll
    for (int hd = 0; hd < 8; ++hd) tot += ssq[hd * 32 + r];
    const float rstd = 1.0f / sqrtf(tot * (1.0f / 512.0f) + EPS);
    __syncthreads();
#pragma unroll
    for (int dt = 0; dt < 2; ++dt)
#pragma unroll
        for (int g = 0; g < 4; ++g) {
            const int d = head * 64 + 32 * dt + 8 * g + 4 * h;
            const f32x4 gv = *(const f32x4*)(gain + d);
            v2u w; w.x = pk2(o[dt][4 * g] * rstd * gv.x, o[dt][4 * g + 1] * rstd * gv.y); w.y = pk2(o[dt][4 * g + 2] * rstd * gv.z, o[dt][4 * g + 3] * rstd * gv.w);
            *(v2u*)(orow + d) = w;
        }
}

__device__ __forceinline__ void attn_finalize2(f32x16 (&o)[2][2], const float (&l_run)[2], LAS float* ssq, const float* gain, bf16* orow, int head0, int r, int h) {
#pragma unroll
    for (int e = 0; e < 2; ++e) {
        const float lt = xhalf_sum(l_run[e]);
        const float inv = 1.0f / lt;
        float sq = 0.f;
#pragma unroll
        for (int dt = 0; dt < 2; ++dt)
#pragma unroll
            for (int i = 0; i < 16; ++i) { o[e][dt][i] *= inv; sq += o[e][dt][i] * o[e][dt][i]; }
        sq = xhalf_sum(sq);
        if (h == 0) ssq[(head0 + e) * 32 + r] = sq;
    }
    __syncthreads();
    float tot = 0.f;
#pragma unroll
    for (int hd = 0; hd < 8; ++hd) tot += ssq[hd * 32 + r];
    const float rstd = 1.0f / sqrtf(tot * (1.0f / 512.0f) + EPS);
    __syncthreads();
#pragma unroll
    for (int e = 0; e < 2; ++e)
#pragma unroll
        for (int dt = 0; dt < 2; ++dt)
#pragma unroll
            for (int g = 0; g < 4; ++g) {
                const int d = (head0 + e) * 64 + 32 * dt + 8 * g + 4 * h;
                const f32x4 gv = *(const f32x4*)(gain + d);
                v2u w; w.x = pk2(o[e][dt][4 * g] * rstd * gv.x, o[e][dt][4 * g + 1] * rstd * gv.y); w.y = pk2(o[e][dt][4 * g + 2] * rstd * gv.z, o[e][dt][4 * g + 3] * rstd * gv.w);
                *(v2u*)(orow + d) = w;
            }
}
__device__ __forceinline__ void attn_phase(Frame& F) {
    constexpr float LOG2E = 1.4426950408889634f;
    LAS float* tb = (LAS float*)F.lds;
    LAS float* rp = (LAS float*)(F.lds + 11264);
    LAS float* ssq = (LAS float*)(F.lds + 11264 + 61440);
    for (int i = F.tid; i < 8 * 352; i += NTHREADS) { const int hd = i / 352, rel = i % 352 - 160; tb[i] = (rel >= -128 && rel <= 128) ? F.t5[t5_bucket_rel(rel) * 8 + hd] * LOG2E : -1e30f; }
    for (int i = F.tid; i < 8 * 15 * 128; i += NTHREADS) { const int co = (i & 127) - 48, hr = i >> 7; rp[i] = (co >= 0 && co <= 30) ? F.rpb[hr * 31 + co] * LOG2E : 0.f; }
    __syncthreads();
    const int head = F.wave, kvh = head >> 2, r = F.lane & 31, h = F.lane >> 5;
    const int vcu = (F.G % 8 == 0) ? (F.bx % 8) * (F.G / 8) + F.bx / 8 : F.bx;
    for (int unit = vcu; unit < 1024; unit += F.G) {
        const int b = unit >> 8, q0 = (unit & 255) * 32;
        const int qtile = (b * S + q0) >> 5;
        const bf16* qblk = F.PROJ + (size_t)head * M * 64 + (size_t)qtile * 2048 + F.lane * 8;
        bf16x8 qf[4];
#pragma unroll
        for (int s = 0; s < 4; ++s) qf[s] = *(const bf16x8*)(qblk + 512 * s);
        float m_run = F.sink[head] * LOG2E, l_run = (h == 0) ? 1.0f : 0.0f;
        f32x16 o[2];
#pragma unroll
        for (int dt = 0; dt < 2; ++dt)
#pragma unroll
            for (int i = 0; i < 16; ++i) o[dt][i] = 0.f;
        const int kt_lo = (q0 >= 128) ? -4 : -(q0 >> 5), kt_hi = (q0 + 32 + 128 <= S) ? 4 : ((S - 32 - q0) >> 5);
        const bf16* kbase = F.PROJ + (size_t)(8 + kvh) * M * 64 + (size_t)qtile * 2048 + F.lane * 8;
        const bf16* vbase = F.VT + (size_t)kvh * M * 64 + (size_t)qtile * 2048 + F.lane * 8;
        f32x16 st;
        { KFrag k0; load_k(k0, kbase + (ptrdiff_t)kt_lo * 2048); st = score_tile(k0, qf); }
        for (int kt = kt_lo; kt <= kt_hi; ++kt) {
            const int ktn = kt < kt_hi ? kt + 1 : kt;
            KFrag kn; VFrag vc;
            load_k(kn, kbase + (ptrdiff_t)ktn * 2048);
            load_v(vc, vbase + (ptrdiff_t)kt * 2048);
            const LAS float* tbl = tb + head * 352 + 160 + 32 * kt - r + 4 * h;
            float sv[16];
#pragma unroll
            for (int i = 0; i < 16; ++i) sv[i] = st[i] + tbl[(i & 3) + 8 * (i >> 2)];
            attn_tile_update<0>(sv, m_run, l_run, o, vc);
            st = score_tile(kn, qf);
        }
        attn_finalize(F, o, l_run, ssq, F.gna, F.MIX + (size_t)(b * S + q0 + r) * D, head, r, h);
    }
    for (int unit = vcu; unit < 512; unit += F.G) {
        const int b = unit >> 7, rg = unit & 127;
        const int rs = (rg - 4) < 0 ? 0 : ((rg - 4) > 120 ? 120 : (rg - 4));
        bf16x8 qf[2][4]; unsigned vm[2]; int cq[2];
#pragma unroll
        for (int qh = 0; qh < 2; ++qh) {
            const int c = 32 * qh + r; cq[qh] = c;
            const int cs = (c - 8) < 0 ? 0 : ((c - 8) > 48 ? 48 : (c - 8));
            const bf16* qblk = F.PROJ + (size_t)(10 + head) * M * 64 + (size_t)(b * 256 + rg * 2 + qh) * 2048 + F.lane * 8;
#pragma unroll
            for (int s = 0; s < 4; ++s) qf[qh][s] = *(const bf16x8*)(qblk + 512 * s);
            unsigned m = 0u;
#pragma unroll
            for (int ct = 0; ct < 2; ++ct)
#pragma unroll
                for (int i = 0; i < 16; ++i) { const int kc = ct * 32 + (i & 3) + 8 * (i >> 2) + 4 * h; m |= (kc >= cs && kc < cs + 16) ? (1u << (16 * ct + i)) : 0u; }
            vm[qh] = m;
        }
        float m_run[2] = {-1e30f, -1e30f}, l_run[2] = {0.0f, 0.0f};
        f32x16 o[2][2];
#pragma unroll
        for (int qh = 0; qh < 2; ++qh)
#pragma unroll
            for (int dt = 0; dt < 2; ++dt)
#pragma unroll
                for (int i = 0; i < 16; ++i) o[qh][dt][i] = 0.f;
        const bf16* kbase = F.PROJ + (size_t)(18 + head) * M * 64 + (size_t)(b * 256 + rs * 2) * 2048 + F.lane * 8;
        const bf16* vbase = F.VT + (size_t)(2 + head) * M * 64 + (size_t)(b * 256 + rs * 2) * 2048 + F.lane * 8;
        f32x16 st[2];
        { KFrag k0; load_k(k0, kbase); st[0] = score_tile(k0, qf[0]); st[1] = score_tile(k0, qf[1]); }
#pragma unroll 1
        for (int kp = 0; kp < 8; ++kp) {
            const int kr = rs + kp;
#pragma unroll
            for (int ct = 0; ct < 2; ++ct) {
                const int kti = 2 * kp + ct;
                const int ktn = kti < 15 ? kti + 1 : kti;
                KFrag kn; VFrag vc;
                load_k(kn, kbase + (size_t)ktn * 2048);
                load_v(vc, vbase + (size_t)kti * 2048);
#pragma unroll
                for (int qh = 0; qh < 2; ++qh) {
                    const LAS float* rprow = rp + (head * 15 + (kr - rg + 7)) * 128 + 48 + ct * 32 + 4 * h - cq[qh] + 15;
                    const unsigned vmc = vm[qh] >> (16 * ct);
                    float sv[16];
#pragma unroll
                    for (int i = 0; i < 16; ++i) sv[i] = ((vmc >> i) & 1u) ? st[qh][i] + rprow[(i & 3) + 8 * (i >> 2)] : -1e30f;
                    if (qh == 0 && ct == 1) attn_tile_update<1>(sv, m_run[qh], l_run[qh], o[qh], vc);
                    else if (qh == 1 && ct == 0) attn_tile_update<2>(sv, m_run[qh], l_run[qh], o[qh], vc);
                    else attn_tile_update<0>(sv, m_run[qh], l_run[qh], o[qh], vc);
                }
                st[0] = score_tile(kn, qf[0]); st[1] = score_tile(kn, qf[1]);
            }
        }
#pragma unroll
        for (int qh = 0; qh < 2; ++qh)
            attn_finalize(F, o[qh], l_run[qh], ssq, F.gnb, F.MIX + (size_t)(b * S + rg * 64 + cq[qh]) * D + 512, head, r, h);
    }
}

__device__ __forceinline__ float tag_f(float v, unsigned tag, unsigned mask) { return __builtin_bit_cast(float, (__builtin_bit_cast(unsigned, v) & ~mask) | tag); }
#define CEX(a, b) do { const float _hi = fmaxf(a, b), _lo = fminf(a, b); a = _hi; b = _lo; } while (0)
template <int N> __device__ __forceinline__ void bitonic_sort_desc(float (&v)[N]) {
#pragma unroll
    for (int k = 2; k <= N; k <<= 1)
#pragma unroll
        for (int j = k >> 1; j > 0; j >>= 1)
#pragma unroll
            for (int i = 0; i < N; ++i) {
                const int l = i ^ j;
                if (l > i) { if ((i & k) == 0) { CEX(v[i], v[l]); } else { CEX(v[l], v[i]); } }
            }
}
__device__ __forceinline__ void bitonic_merge16_desc(float (&v)[16]) {
#pragma unroll
    for (int j = 8; j > 0; j >>= 1)
#pragma unroll
        for (int i = 0; i < 16; ++i) { const int l = i ^ j; if (l > i) CEX(v[i], v[l]); }
}
__device__ __forceinline__ void top16_merge(float (&a)[16], const float (&b)[16]) {
#pragma unroll
    for (int i = 0; i < 16; ++i) a[i] = fmaxf(a[i], b[15 - i]);
    bitonic_merge16_desc(a);
}
__device__ __forceinline__ void top16_pair(const f32x16 (&st)[4], int h, float (&out)[16]) {
    float g[4][16];
#pragma unroll
    for (int nt = 0; nt < 4; ++nt) {
#pragma unroll
        for (int i = 0; i < 16; ++i) g[nt][i] = tag_f(st[nt][i], (unsigned)(32 * nt + crow(i, h)), 127u);
        bitonic_sort_desc<16>(g[nt]);
    }
    top16_merge(g[0], g[1]); top16_merge(g[2], g[3]); top16_merge(g[0], g[2]);
    float th[16];
#pragma unroll
    for (int i = 0; i < 16; ++i) halves(g[0][i], out[i], th[i]);
    top16_merge(out, th);
}

__device__ __forceinline__ void route_phase(Frame& F) {
    const int r = F.lane & 31, h = F.lane >> 5;
    const int head = F.bx & 7;
    for (int i = F.tid; i < 4096; i += NTHREADS) ((LAS v4u*)F.lds)[i] = ((const v4u*)(F.SK + (size_t)head * 2 * 128 * 128))[i];
    __syncthreads();
    LAS int* scr = (LAS int*)(F.lds + 65536 + F.wave * 8192) + F.lane;
    for (int tg = F.bx >> 3; tg < 128; tg += F.G >> 3) {
        const int t0 = (tg * 8 + F.wave) * 32;
        float lst[2][16];
#pragma unroll
        for (int half = 0; half < 2; ++half) {
            const bf16* qblk = F.QP + (size_t)(head * 4 + half * 2) * M * 64 + (size_t)(t0 >> 5) * 2048 + F.lane * 8;
            bf16x8 qf[8];
#pragma unroll
            for (int s = 0; s < 8; ++s) qf[s] = *(const bf16x8*)(qblk + (size_t)(s >> 2) * M * 64 + (s & 3) * 512);
            const LAS unsigned char* sk = F.lds + half * 32768 + F.lane * 16;
            f32x16 st[4];
#pragma unroll
            for (int nt = 0; nt < 4; ++nt) {
#pragma unroll
                for (int i = 0; i < 16; ++i) st[nt][i] = 0.f;
#pragma unroll
                for (int s = 0; s < 8; ++s) st[nt] = MFMA32(*(const LAS bf16x8*)(sk + (nt * 8 + s) * 1024), qf[s], st[nt]);
                __builtin_amdgcn_sched_barrier(0);
            }
            top16_pair(st, h, lst[half]);
            __builtin_amdgcn_sched_barrier(0);
        }
#pragma unroll
        for (int i = 0; i < 16; ++i) { scr[i * 64] = (int)(__builtin_bit_cast(unsigned, lst[0][i]) & 127u); scr[(16 + i) * 64] = (int)(__builtin_bit_cast(unsigned, lst[1][i]) & 127u); }
        constexpr float NEGINF = -3.0e38f;
        float win[16], tmp[16];
#pragma unroll
        for (int j = 0; j < 16; ++j) win[j] = tag_f(lst[0][0] + lst[1][j], (unsigned)j, 255u);
#pragma unroll
        for (int i = 1; i < 8; ++i) {
#pragma unroll
            for (int j = 0; j < 16; ++j) tmp[j] = ((i + 1) * (j + 1) <= 16) ? tag_f(lst[0][i] + lst[1][j], (unsigned)(i * 16 + j), 255u) : NEGINF;
            top16_merge(win, tmp);
        }
#pragma unroll
        for (int j = 0; j < 16; ++j) tmp[j] = (j < 8) ? tag_f(lst[0][8 + j] + lst[1][0], (unsigned)((8 + j) * 16), 255u) : NEGINF;
        top16_merge(win, tmp);
        float e[16]; float es = 0.f;
#pragma unroll
        for (int k = 0; k < 16; ++k) { e[k] = __expf(win[k] - win[0]); es += e[k]; }
        const float einv = 1.0f / es;
        LDS_WAIT(); asm volatile("" ::: "memory");
        int ex[16];
#pragma unroll
        for (int k = 0; k < 16; ++k) { const unsigned code = __builtin_bit_cast(unsigned, win[k]) & 255u; ex[k] = scr[(code >> 4) * 64] * 128 + scr[(16 + (code & 15u)) * 64]; }
        if (h == 0) {
            int* ip = F.IDX + (size_t)(t0 + r) * 128 + head * 16; float* gp = F.GT + (size_t)(t0 + r) * 128 + head * 16;
#pragma unroll
            for (int k4 = 0; k4 < 4; ++k4) {
                *(v4u*)(ip + 4 * k4) = (v4u){(unsigned)ex[4 * k4], (unsigned)ex[4 * k4 + 1], (unsigned)ex[4 * k4 + 2], (unsigned)ex[4 * k4 + 3]};
                *(f32x4*)(gp + 4 * k4) = (f32x4){e[4 * k4] * einv, e[4 * k4 + 1] * einv, e[4 * k4 + 2] * einv, e[4 * k4 + 3] * einv};
            }
        }
        LDS_WAIT(); asm volatile("" ::: "memory");
    }
}

__device__ __forceinline__ float gelu_tanh(float z) {
    const float u = 0.7978845608028654f * (z + 0.044715f * z * z * z);
    const float t = 1.0f - 2.0f / (__expf(2.0f * u) + 1.0f);
    return 0.5f * z * (1.0f + t);
}
__device__ __forceinline__ int rev4(int k) { return ((k & 1) << 3) | ((k & 2) << 1) | ((k & 4) >> 1) | ((k & 8) >> 3); }
__device__ __forceinline__ int idot16(const v4u& a, const v4u& b) {
    int r = __builtin_amdgcn_sdot4((int)a.x, (int)b.x, 0, false); r = __builtin_amdgcn_sdot4((int)a.y, (int)b.y, r, false);
    r = __builtin_amdgcn_sdot4((int)a.z, (int)b.z, r, false); return __builtin_amdgcn_sdot4((int)a.w, (int)b.w, r, false);
}
__device__ __forceinline__ void fma4u(float (&acc)[16], int o, unsigned w, float a) {
    acc[o + 0] += a * (float)(w & 0xffu); acc[o + 1] += a * (float)((w >> 8) & 0xffu); acc[o + 2] += a * (float)((w >> 16) & 0xffu); acc[o + 3] += a * (float)(w >> 24);
}
constexpr int MB_IDX_PITCH = 528, MB_AUX_OFF = 8 * 528, MB_AUX_PITCH = 144, MB_BYTES = 6144;
struct VMeta { v4u n[4]; v4u a; };
__device__ __forceinline__ void v_gather(v4u (&vq)[16], const VMeta& m, const unsigned char* vbase, unsigned c16) {
#pragma unroll
    for (int i = 0; i < 16; ++i) vq[i] = *(const v4u*)(vbase + (unsigned)(m.n[i >> 2][i & 3] * 128u + c16));
}
__device__ __forceinline__ void v_accumulate(int (&acc)[16], const v4u (&vq)[16], const v4u al) {
#pragma unroll
    for (int a = 0; a < 4; ++a)
#pragma unroll
        for (int b = 0; b < 4; ++b) {
            const unsigned r0 = vq[4 * a + 0][b], r1 = vq[4 * a + 1][b], r2 = vq[4 * a + 2][b], r3 = vq[4 * a + 3][b];
            const unsigned t0 = __builtin_amdgcn_perm(r1, r0, 0x05010400u), t1 = __builtin_amdgcn_perm(r1, r0, 0x07030602u);
            const unsigned t2 = __builtin_amdgcn_perm(r3, r2, 0x05010400u), t3 = __builtin_amdgcn_perm(r3, r2, 0x07030602u);
            const unsigned c0 = __builtin_amdgcn_perm(t2, t0, 0x05040100u), c1 = __builtin_amdgcn_perm(t2, t0, 0x07060302u);
            const unsigned c2 = __builtin_amdgcn_perm(t3, t1, 0x05040100u), c3 = __builtin_amdgcn_perm(t3, t1, 0x07060302u);
            acc[4 * b + 0] = __builtin_amdgcn_sdot4((int)c0, (int)al[a], acc[4 * b + 0], false);
            acc[4 * b + 1] = __builtin_amdgcn_sdot4((int)c1, (int)al[a], acc[4 * b + 1], false);
            acc[4 * b + 2] = __builtin_amdgcn_sdot4((int)c2, (int)al[a], acc[4 * b + 2], false);
            acc[4 * b + 3] = __builtin_amdgcn_sdot4((int)c3, (int)al[a], acc[4 * b + 3], false);
        }
}

__device__ __forceinline__ void peer_fused_phase(Frame& F, bf16* pout) {
    const int lane = F.lane, g = lane >> 3, c = lane & 7;
    const bool b0 = c & 1, b1 = c & 2, b2 = c & 4;
    const int i0c = 8 * (c & 1) + 4 * ((c >> 1) & 1) + 2 * ((c >> 2) & 1);
    LAS unsigned char* wl = F.lds + F.wave * 16384;
    constexpr int L_IDX = 0, L_AUXZ = 16 * MB_IDX_PITCH, L_AUXV = L_AUXZ + 2 * 8 * MB_AUX_PITCH;
    const int xcc = (int)(xb_xcc_id() & 7u);
    const int it0 = F.gw * 2;
    const int tkl = lane >> 3, q = lane & 7;
#pragma unroll
    for (int item = 0; item < 2; ++item) {
        const v4u* ip = (const v4u*)(F.IDX + (size_t)((it0 + item) * 8 + tkl) * 128 + 16 * q);
        const v4u a0 = ip[0], a1 = ip[1], a2 = ip[2], a3 = ip[3];
        LAS v4u* p = (LAS v4u*)(wl + L_IDX + (item * 8 + tkl) * MB_IDX_PITCH + q * 64);
        p[0] = a0; p[1] = a1; p[2] = a2; p[3] = a3;
    }
    int zacc[16][2];
#pragma unroll
    for (int i = 0; i < 16; ++i) { zacc[i][0] = 0; zacc[i][1] = 0; }
    {
        int buf = 0;
        { const v4u x0 = *(const v4u*)(F.X8 + (size_t)(it0 * 8 + tkl) * D + xcc * 128 + 16 * q); *(LAS v4u*)(wl + L_AUXZ + tkl * MB_AUX_PITCH + q * 16) = x0; }
#pragma unroll 1
        for (int k = 0; k < 8; ++k) {
            const int s = (xcc + k) & 7, sn = (xcc + k + 1) & 7;
            const unsigned char* ubase = F.U8 + (size_t)s * NEXP * 128;
#pragma unroll
            for (int item = 0; item < 2; ++item) {
                const v4u xn = *(const v4u*)(F.X8 + (size_t)((item == 0 ? it0 + 1 : it0) * 8 + tkl) * D + (item == 0 ? s : sn) * 128 + 16 * q);
                const LAS unsigned char* ib = wl + L_IDX + item * 8 * MB_IDX_PITCH;
                const LAS unsigned char* xb = wl + L_AUXZ + buf * 8 * MB_AUX_PITCH;
#pragma unroll
                for (int tt = 0; tt < 8; ++tt) {
                    const LAS v4u* ip = (const LAS v4u*)(ib + tt * MB_IDX_PITCH + g * 64);
                    const v4u n0 = ip[0], n1 = ip[1], n2 = ip[2], n3 = ip[3];
                    const v4u xq = *(const LAS v4u*)(xb + tt * MB_AUX_PITCH + c * 16);
                    const unsigned e[16] = {n0.x, n0.y, n0.z, n0.w, n1.x, n1.y, n1.z, n1.w, n2.x, n2.y, n2.z, n2.w, n3.x, n3.y, n3.z, n3.w};
                    v4u uq[16];
#pragma unroll
                    for (int i = 0; i < 16; ++i) uq[i] = *(const v4u*)(ubase + (unsigned)(e[i] * 128u + (unsigned)c * 16u));
                    int p[16];
#pragma unroll
                    for (int i = 0; i < 16; ++i) p[i] = idot16(uq[i], xq);
                    int q8_[8], q4_[4], q2_[2];
#pragma unroll
                    for (int i = 0; i < 8; ++i) { const int keep = b0 ? p[8 + i] : p[i], send = b0 ? p[i] : p[8 + i]; q8_[i] = keep + dppi<DPP_XOR1>(send); }
#pragma unroll
                    for (int i = 0; i < 4; ++i) { const int keep = b1 ? q8_[4 + i] : q8_[i], send = b1 ? q8_[i] : q8_[4 + i]; q4_[i] = keep + dppi<DPP_XOR2>(send); }
#pragma unroll
                    for (int i = 0; i < 2; ++i) { const int keep = b2 ? q4_[2 + i] : q4_[i], send = b2 ? q4_[i] : q4_[2 + i]; q2_[i] = keep + __shfl_xor(send, 4); }
                    zacc[item * 8 + tt][0] += q2_[0]; zacc[item * 8 + tt][1] += q2_[1];
                }
                buf ^= 1;
                *(LAS v4u*)(wl + L_AUXZ + buf * 8 * MB_AUX_PITCH + tkl * MB_AUX_PITCH + q * 16) = xn;
                __builtin_amdgcn_sched_barrier(0);
            }
        }
    }
#pragma unroll
    for (int tk = 0; tk < 16; ++tk) {
        const int t = it0 * 8 + tk, j0 = 16 * g + i0c;
        const v2u e = *(const LAS v2u*)(wl + L_IDX + tk * MB_IDX_PITCH + j0 * 4);
        const float* gp = F.GT + (size_t)t * 128 + j0;
        const float sx = F.SX[t];
        const float a0 = gelu_tanh((float)zacc[tk][0] * (sx * F.SU[e.x])) * gp[0] * F.SV[e.x];
        const float a1 = gelu_tanh((float)zacc[tk][1] * (sx * F.SU[e.y])) * gp[1] * F.SV[e.y];
        const float am = wave_max(fmaxf(fabsf(a0), fabsf(a1)));
        const float inv = am > 0.f ? 127.0f / am : 0.f;
        *(LAS unsigned short*)(wl + L_AUXV + tk * MB_AUX_PITCH + j0) = (unsigned short)(q8(a0, inv, 0) | (q8(a1, inv, 0) << 8));
        zacc[tk][0] = __builtin_bit_cast(int, am * (1.0f / 127.0f));
    }
    {
        const int tk = lane >> 3;
        float sa2[2];
#pragma unroll
        for (int item = 0; item < 2; ++item) { float v = 0.f;
#pragma unroll
            for (int j = 0; j < 8; ++j) v = (tk == j) ? __builtin_bit_cast(float, zacc[item * 8 + j][0]) : v;
            sa2[item] = v; }
#pragma unroll 1
        for (int k = 0; k < 8; ++k) {
            const int s = (xcc + k) & 7;
            const unsigned char* vbase = F.V8 + (size_t)s * NEXP * 128;
#pragma unroll
            for (int item = 0; item < 2; ++item) {
                const LAS unsigned char* ib = wl + L_IDX + (item * 8 + tk) * MB_IDX_PITCH;
                const LAS unsigned char* ab = wl + L_AUXV + (item * 8 + tk) * MB_AUX_PITCH;
                const int t = (it0 + item) * 8 + tk;
                int acc[16];
#pragma unroll
                for (int i = 0; i < 16; ++i) acc[i] = 0;
                VMeta mt[2]; v4u vq[2][16];
#pragma unroll
                for (int u = 0; u < 2; ++u) { const LAS v4u* ip = (const LAS v4u*)(ib + u * 64); mt[u].n[0] = ip[0]; mt[u].n[1] = ip[1]; mt[u].n[2] = ip[2]; mt[u].n[3] = ip[3]; mt[u].a = *(const LAS v4u*)(ab + u * 16); }
                v_gather(vq[0], mt[0], vbase, (unsigned)c * 16u);
#pragma unroll
                for (int i = 0; i < 8; ++i) {
                    const int cur = i & 1, nxt = cur ^ 1;
                    const v4u al = mt[cur].a;
                    if (i + 1 < 8) v_gather(vq[nxt], mt[nxt], vbase, (unsigned)c * 16u);
                    if (i + 2 < 8) { const LAS v4u* ip = (const LAS v4u*)(ib + (i + 2) * 64); mt[cur].n[0] = ip[0]; mt[cur].n[1] = ip[1]; mt[cur].n[2] = ip[2]; mt[cur].n[3] = ip[3]; mt[cur].a = *(const LAS v4u*)(ab + (i + 2) * 16); }
                    v_accumulate(acc, vq[cur], al);
                }
                const float sa = sa2[item];
                v4u w0, w1;
                w0.x = pk2(sa * (float)acc[0], sa * (float)acc[1]);   w0.y = pk2(sa * (float)acc[2], sa * (float)acc[3]);
                w0.z = pk2(sa * (float)acc[4], sa * (float)acc[5]);   w0.w = pk2(sa * (float)acc[6], sa * (float)acc[7]);
                w1.x = pk2(sa * (float)acc[8], sa * (float)acc[9]);   w1.y = pk2(sa * (float)acc[10], sa * (float)acc[11]);
                w1.z = pk2(sa * (float)acc[12], sa * (float)acc[13]); w1.w = pk2(sa * (float)acc[14], sa * (float)acc[15]);
                v4u* po = (v4u*)(pout + (size_t)t * D + s * 128 + 16 * c);
                po[0] = w0; po[1] = w1;
                __builtin_amdgcn_sched_barrier(0);
            }
        }
    }
    asm volatile("s_waitcnt vmcnt(0)" ::: "memory");
    {
        int ln = lane; asm volatile("" : "+v"(ln));
        const int tb = it0 * 8;
        const float* gate2 = F.ada + (size_t)(tb >> 13) * 6144 + 5120;
        f32x4 gt[4], gf[4];
#pragma unroll
        for (int j = 0; j < 4; ++j) { gt[j] = ((const f32x4*)gate2)[ln + 64 * j]; gf[j] = ((const f32x4*)F.gfin)[ln + 64 * j]; }
        for (int k = 0; k < 16; k += 2)
#pragma unroll
        for (int u2 = 0; u2 < 2; ++u2) { const int t = tb + k + u2;
            f32x4* xr = (f32x4*)(F.out + (size_t)t * D) + ln;
            const bf16* x1row = F.X1 + (size_t)t * D;
            const v2u* pr = (const v2u*)(pout + (size_t)t * D) + ln;
            f32x4 v[4]; float ss = 0.f;
#pragma unroll
            for (int j = 0; j < 4; ++j) {
                const f32x4 x1 = load_row4(x1row, ln + 64 * j); const v2u pw = pr[64 * j];
                f32x4 y; y.x = x1.x + gt[j].x * bflo(pw.x); y.y = x1.y + gt[j].y * bfhi(pw.x); y.z = x1.z + gt[j].z * bflo(pw.y); y.w = x1.w + gt[j].w * bfhi(pw.y);
                v[j] = y; ss += (y.x * y.x + y.y * y.y) + (y.z * y.z + y.w * y.w);
            }
            ss = wave_sum(ss);
            const float rstd = 1.0f / sqrtf(ss * (1.0f / 1024.0f) + EPS);
#pragma unroll
            for (int j = 0; j < 4; ++j) xr[64 * j] = v[j] * rstd * gf[j];
        }
    }
}

__global__ void __launch_bounds__(NTHREADS, 2) hymba_fwd(Args args) {
    extern __shared__ __attribute__((aligned(16))) unsigned char lds[];
    Frame F;
    F.lds = (LAS unsigned char*)lds;
    F.tid = threadIdx.x; F.lane = F.tid & 63; F.wave = __builtin_amdgcn_readfirstlane(F.tid >> 6);
    F.G = gridDim.x; F.bx = blockIdx.x; F.gw = F.bx * NWAVES + F.wave; F.ngw = F.G * NWAVES;
    unsigned char* ws = args.ws;
    F.x = args.in[0]; F.c = args.in[1]; F.w_ada = args.in[2]; F.b_ada = args.in[3]; F.g1 = args.in[4]; F.w_in = args.in[5]; F.sink = args.in[6]; F.t5 = args.in[7];
    F.rpb = args.in[8]; F.gna = args.in[9]; F.gnb = args.in[10]; F.w_out = args.in[11]; F.g2 = args.in[12]; F.w_query = args.in[13]; F.sub_keys = args.in[14];
    F.uexp = args.in[15]; F.vexp = args.in[16]; F.gfin = args.in[17]; F.out = args.out;
    F.ada = (float*)(ws + WS_ADA); F.WO = (bf16*)(ws + WS_WO); F.WQ = (bf16*)(ws + WS_WQ); F.SK = (bf16*)(ws + WS_SK);
    F.W1A = (bf16*)(ws + WS_W1A); F.H = (bf16*)(ws + WS_H); F.WVT = (bf16*)(ws + WS_WVT); F.U8 = ws + WS_U8; F.V8 = ws + WS_V8; F.X8 = ws + WS_X8; F.SU = (float*)(ws + WS_SU); F.SV = (float*)(ws + WS_SV); F.SX = (float*)(ws + WS_SX); F.ctl = (unsigned*)(ws + WS_CTL); F.X1 = (bf16*)(ws + WS_X1);
    F.PROJ = (bf16*)(ws + WS_PROJ); F.VT = (bf16*)(ws + WS_VT); F.QP = (bf16*)(ws + WS_QP); F.MIX = (bf16*)(ws + WS_MIX); F.IDX = (int*)(ws + WS_IDX); F.GT = (float*)(ws + WS_G);

    volatile LAS unsigned* MISC = (volatile LAS unsigned*)(F.lds + MISC_OFF); F.MISC = MISC;
    if (F.tid < 32) MISC[F.tid] = 0u;
    __syncthreads();
    XcdBarrier bar = xcd_barrier_post((unsigned*)(ws + WS_CTL) + CW_BAR, MISC + 8);

    p0_prologue(F);
    if (F.tid == 0) {
        unsigned sp = 0;
        while (__hip_atomic_load(F.ctl + CW_ADA, __ATOMIC_RELAXED, __HIP_MEMORY_SCOPE_AGENT) < 32u) { __builtin_amdgcn_s_sleep(2); if (++sp > (1u << 22)) break; }
        __builtin_amdgcn_fence(__ATOMIC_ACQUIRE, "agent");
        asm volatile("s_waitcnt vmcnt(0)" ::: "memory");
    }
    __syncthreads();
    {
        const int rpw = M / F.ngw, mb = F.gw * rpw; const float* ad = F.ada + (size_t)(mb >> 13) * 6144;
        int ln = F.lane; asm volatile("" : "+v"(ln));
        f32x4 gs[4], sh[4]; load_mod_vectors(gs, sh, F.g1, ad, ad + 1024, ln);
        for (int k = 0; k < rpw; k += 2) {
#pragma unroll
            for (int u = 0; u < 2; ++u) { const int m = mb + k + u; norm_mod_row<false, float>(F.x + (size_t)m * D, F.H + (size_t)m * D, gs, sh, ln); } }
    }
    xcd_barrier(bar);
    { pg8::Gemm g{F.H, F.W1A, M + NVT, N1A + M, D, D, D}; pg8::Gemm1Order So; So.init(F.G, F.bx);
      pg8::EpiGemm1 E{pg8::EpiQKFrag{F.PROJ, M}, pg8::EpiVTFrag{F.VT, M}};
      pg8::gemm_phase<pg8::EpiGemm1, pg8::Gemm1Order, true, true>(F.lds, g, So, E); }
    xcd_barrier(bar);
    attn_phase(F);
    xcd_barrier(bar);
    { pg8::Gemm g{F.MIX, F.WO, M, D, D, D, D}; pg8::StaticOrder So; So.init(M, D, F.G, F.bx); pg8::EpiResGate E{F.x, F.ada, F.X1};
      pg8::gemm_phase<pg8::EpiResGate, pg8::StaticOrder, true, true>(F.lds, g, So, E); }
    xcd_barrier(bar);
    {
        const int rpw = M / F.ngw, mb = F.gw * rpw; const float* ad = F.ada + (size_t)(mb >> 13) * 6144;
        int ln = F.lane; asm volatile("" : "+v"(ln));
        f32x4 gs[4], sh[4]; load_mod_vectors(gs, sh, F.g2, ad + 3072, ad + 4096, ln);
        for (int k = 0; k < rpw; k += 2) {
#pragma unroll
            for (int u = 0; u < 2; ++u) { const int m = mb + k + u; norm_mod_row<true, bf16>(F.X1 + (size_t)m * D, F.H + (size_t)m * D, gs, sh, ln, F.X8 + (size_t)m * D, F.SX + m); } }
    }
    xcd_barrier(bar);
    { pg8::Gemm g{F.H, F.WQ, M, NQ, D, D, D}; pg8::StaticOrder So; So.init(M, NQ, F.G, F.bx); pg8::EpiQKFrag E{F.QP, M};
      pg8::gemm_phase<pg8::EpiQKFrag, pg8::StaticOrder, true, true>(F.lds, g, So, E); }
    xcd_barrier(bar);
    route_phase(F);
    xcd_barrier(bar);
    peer_fused_phase(F, F.MIX);
}

extern "C" void kernel_launch(void* const* d_in, const int* in_sizes, int n_in, void* d_out, int out_size, void* d_ws, size_t ws_size, hipStream_t stream) {
    static int grid = 0;
    if (grid == 0) {
        if (n_in != 18 || out_size != M * D || ws_size < WS_END) { fprintf(stderr, "kernel_launch: unexpected shapes (n_in %d out %d ws %zu)\n", n_in, out_size, ws_size); grid = -1; return; }
        int dev = 0, cus = 0, per_cu = 0;
        if (hipGetDevice(&dev) != hipSuccess || hipDeviceGetAttribute(&cus, hipDeviceAttributeMultiprocessorCount, dev) != hipSuccess) { grid = -1; return; }
        if (hipFuncSetAttribute((const void*)hymba_fwd, hipFuncAttributeMaxDynamicSharedMemorySize, LDS_BYTES) != hipSuccess) { fprintf(stderr, "kernel_launch: hipFuncSetAttribute failed\n"); grid = -1; return; }
        if (hipOccupancyMaxActiveBlocksPerMultiprocessor(&per_cu, (const void*)hymba_fwd, NTHREADS, LDS_BYTES) != hipSuccess || per_cu < 1) { fprintf(stderr, "kernel_launch: occupancy query says %d\n", per_cu); per_cu = 1; }
        (void)hipGetLastError();
        grid = cus;
    }
    if (grid < 0) return;
    if (hipMemsetAsync((char*)d_ws + WS_CTL, 0, CTL_ZERO_BYTES, stream) != hipSuccess) return;
    Args a{};
    for (int i = 0; i < 18; ++i) a.in[i] = (const float*)d_in[i];
    a.out = (float*)d_out; a.ws = (unsigned char*)d_ws;
    hipLaunchKernelGGL(hymba_fwd, dim3(grid), dim3(NTHREADS), LDS_BYTES, stream, a);
}
```

```cpp
#include <hip/hip_runtime.h>
#include <cstdio>
#include <cstdint>

#define GAS __attribute__((address_space(1)))
#define LAS __attribute__((address_space(3)))
typedef unsigned short bf16;
typedef unsigned v4u __attribute__((ext_vector_type(4)));
typedef unsigned v2u __attribute__((ext_vector_type(2)));
typedef float f32x4 __attribute__((ext_vector_type(4)));
typedef float f32x16 __attribute__((ext_vector_type(16)));
typedef short bf16x8 __attribute__((ext_vector_type(8)));
typedef __bf16 bf16x2v __attribute__((ext_vector_type(2)));

#define MFMA32(a, b, c) __builtin_amdgcn_mfma_f32_32x32x16_bf16((a), (b), (c), 0, 0, 0)
#define LDS_WAIT() asm volatile("s_waitcnt lgkmcnt(0)" ::: "memory")

constexpr int NB = 4, S = 8192, D = 1024, M = NB * S;
constexpr int N1A = 1792;
constexpr int NVT = 768;
constexpr int NQ = 2048;
constexpr int NEXP = 16384;
constexpr float EPS = 1e-6f;
constexpr int NWAVES = 8, NTHREADS = 512;

constexpr size_t MiB = 1u << 20;
constexpr size_t WS_CTL = 0, CTL_ZERO_BYTES = 64 * 1024;
constexpr size_t WS_ADA = 1 * MiB;
constexpr size_t WS_WO = 2 * MiB;
constexpr size_t WS_WQ = 4 * MiB;
constexpr size_t WS_SK = 8 * MiB;
constexpr size_t WS_WBIG = 10 * MiB;
constexpr size_t WS_W1A = WS_WBIG, WS_H = WS_WBIG + (size_t)N1A * D * 2, WS_WVT = WS_H + (size_t)M * D * 2;
constexpr size_t WS_SU = 1 * MiB + 256 * 1024, WS_SV = 1 * MiB + 512 * 1024, WS_SX = 1 * MiB + 768 * 1024;
constexpr size_t WS_U8 = 80 * MiB, WS_V8 = 96 * MiB;
constexpr size_t WS_X8 = 112 * MiB;
constexpr size_t WS_PROJ = 144 * MiB;
constexpr size_t WS_VT = 256 * MiB;
constexpr size_t WS_QP = 144 * MiB;
constexpr size_t WS_MIX = 306 * MiB;
constexpr size_t WS_IDX = 372 * MiB;
constexpr size_t WS_G = 388 * MiB;
constexpr size_t WS_X1 = 416 * MiB;
constexpr size_t WS_END = 480 * MiB;
static_assert(WS_VT + (size_t)NVT * M * 2 <= WS_MIX, "ws map");
static_assert(WS_WVT + (size_t)NVT * D * 2 <= WS_U8 && WS_X8 + (size_t)M * D <= WS_PROJ, "ws map");
static_assert(WS_QP + (size_t)M * NQ * 2 <= WS_MIX, "ws map");
constexpr int CW_BAR = 4096;
constexpr int CW_ADA = 12288;

static_assert((12288 + 64) * 4 <= (int)CTL_ZERO_BYTES && (4096 + 3456) * 4 <= (int)CTL_ZERO_BYTES, "control words inside the per-call memset");
constexpr int LDS_BYTES = 147456;
constexpr int MISC_OFF = 131072 + 320;

typedef float f32x2v __attribute__((ext_vector_type(2)));
__device__ __forceinline__ unsigned pk2(float lo, float hi) { f32x2v v; v.x = lo; v.y = hi; return __builtin_bit_cast(unsigned, __builtin_convertvector(v, bf16x2v)); }
__device__ __forceinline__ float bflo(unsigned w) { return __builtin_bit_cast(float, w << 16); }
__device__ __forceinline__ float bfhi(unsigned w) { return __builtin_bit_cast(float, w & 0xffff0000u); }
constexpr int DPP_XOR1 = 0xB1, DPP_XOR2 = 0x4E, DPP_ROR4 = 0x124, DPP_ROR8 = 0x128;
template <int CTRL> __device__ __forceinline__ float dppf(float x) { return __builtin_bit_cast(float, __builtin_amdgcn_mov_dpp(__builtin_bit_cast(int, x), CTRL, 0xf, 0xf, true)); }
template <int CTRL> __device__ __forceinline__ int dppi(int x) { return __builtin_amdgcn_mov_dpp(x, CTRL, 0xf, 0xf, true); }
__device__ __forceinline__ void halves(float x, float& lo, float& hi) {
    auto t = __builtin_amdgcn_permlane32_swap(__builtin_bit_cast(unsigned, x), __builtin_bit_cast(unsigned, x), false, false);
    const unsigned a = t[0], b = t[1];
    lo = __builtin_bit_cast(float, a); hi = __builtin_bit_cast(float, b);
}
__device__ __forceinline__ float xhalf_max(float x) { float a, b; halves(x, a, b); return fmaxf(a, b); }
__device__ __forceinline__ float xhalf_sum(float x) { float a, b; halves(x, a, b); return a + b; }
__device__ __forceinline__ float wave_sum(float v) {
    v += dppf<DPP_XOR1>(v); v += dppf<DPP_XOR2>(v); v += dppf<DPP_ROR4>(v); v += dppf<DPP_ROR8>(v);
    auto s = __builtin_amdgcn_permlane16_swap(__builtin_bit_cast(unsigned, v), __builtin_bit_cast(unsigned, v), false, false);
    const unsigned s0 = s[0], s1 = s[1];
    v = __builtin_bit_cast(float, s0) + __builtin_bit_cast(float, s1);
    return xhalf_sum(v);
}
__device__ __forceinline__ float wave_max(float v) {
    v = fmaxf(v, dppf<DPP_XOR1>(v)); v = fmaxf(v, dppf<DPP_XOR2>(v)); v = fmaxf(v, dppf<DPP_ROR4>(v)); v = fmaxf(v, dppf<DPP_ROR8>(v));
    auto s = __builtin_amdgcn_permlane16_swap(__builtin_bit_cast(unsigned, v), __builtin_bit_cast(unsigned, v), false, false);
    const unsigned s0 = s[0], s1 = s[1];
    v = fmaxf(__builtin_bit_cast(float, s0), __builtin_bit_cast(float, s1));
    return xhalf_max(v);
}
__device__ __forceinline__ unsigned q8(float v, float inv, int bias) {
    float q = rintf(v * inv); q = fminf(fmaxf(q, -127.f), 127.f);
    return (unsigned)((int)q + bias) & 0xffu;
}
__device__ __forceinline__ unsigned q8x4(const f32x4& v, float inv, int bias) { return q8(v.x, inv, bias) | (q8(v.y, inv, bias) << 8) | (q8(v.z, inv, bias) << 16) | (q8(v.w, inv, bias) << 24); }
__device__ __forceinline__ int crow(int i, int h) { return (i & 3) + 8 * (i >> 2) + 4 * h; }

#define XB_TMO      128
#define XB_XCNT(j)  (256  + 64 * (j))
#define XB_XSUB(j)  (1280 + 64 * (j))
#define XB_XGEN(j)  (2304 + 64 * (j))
#define XB_TOP      3328
#define XB_TOPGEN   3392
#define XCD_BAR_WORDS 3456
#define XB_SPIN_CAP (1u << 18)

__device__ __forceinline__ unsigned xb_ld(unsigned* p)              { return __hip_atomic_load(p, __ATOMIC_RELAXED, __HIP_MEMORY_SCOPE_AGENT); }
__device__ __forceinline__ unsigned xb_add(unsigned* p, unsigned v) { return __hip_atomic_fetch_add(p, v, __ATOMIC_RELAXED, __HIP_MEMORY_SCOPE_AGENT); }
__device__ __forceinline__ unsigned xb_xcc_id() { return (unsigned)__builtin_amdgcn_s_getreg((3 << 11) | 20) & 0xFu; }
#define XB_SPIN(cond, bar) do { unsigned _sp = 0; while (cond) { __builtin_amdgcn_s_sleep(1); \
    if ((++_sp & 255u) == 0u) { if (xb_ld(&(bar)[XB_TMO])) break; if (_sp > XB_SPIN_CAP) { atomicAdd(&(bar)[XB_TMO], 1u); break; } } } } while (0)

struct XcdBarrier {
    unsigned* bar; unsigned x;
    volatile LAS unsigned* st;
};
__device__ __forceinline__ XcdBarrier xcd_barrier_post(unsigned* bar, volatile LAS unsigned* st) {
    XcdBarrier b; b.bar = bar; b.x = xb_xcc_id(); b.st = st;
    if (threadIdx.x == 0) (void)xb_add(&bar[XB_XCNT(b.x)], 1u);
    return b;
}
__device__ __forceinline__ void xcd_barrier_complete(unsigned* bar, unsigned x, unsigned& nloc, unsigned& nx) {
    const unsigned G = gridDim.x * gridDim.y * gridDim.z;
    unsigned sum, cnt, mine, sp = 0u;
    for (;;) {
        sum = 0u; cnt = 0u; mine = 0u;
#pragma unroll
        for (unsigned j = 0; j < 16; ++j) { const unsigned c = xb_ld(&bar[XB_XCNT(j)]); sum += c; cnt += (c > 0u) ? 1u : 0u; mine = (j == x) ? c : mine; }
        if (sum == G) break;
        __builtin_amdgcn_s_sleep(1);
        if ((++sp & 255u) == 0u) { if (xb_ld(&bar[XB_TMO])) break; if (sp > XB_SPIN_CAP) { atomicAdd(&bar[XB_TMO], 1u); break; } }
    }
    nloc = mine > 0u ? mine : 1u; nx = cnt > 0u ? cnt : 1u;
}
__device__ __forceinline__ void xcd_barrier(const XcdBarrier& b) {
    asm volatile("s_waitcnt vmcnt(0)" ::: "memory");
    __syncthreads();
    if (threadIdx.x == 0) {
        unsigned* bar = b.bar;
        __builtin_amdgcn_s_waitcnt(0);
        unsigned nloc = b.st[0], nx = b.st[1];
        if (nloc == 0u) { xcd_barrier_complete(bar, b.x, nloc, nx); b.st[0] = nloc; b.st[1] = nx; }
        const unsigned old = xb_add(&bar[XB_XSUB(b.x)], 1u);
        const unsigned gen = old / nloc;
        if (old + 1u == (gen + 1u) * nloc) {
            __builtin_amdgcn_fence(__ATOMIC_RELEASE, "agent");
            asm volatile("s_waitcnt vmcnt(0)" ::: "memory");
            const unsigned og = xb_add(&bar[XB_TOP], 1u);
            const unsigned tg = og / nx;
            if (og + 1u == (tg + 1u) * nx) xb_add(&bar[XB_TOPGEN], 1u);
            else XB_SPIN(xb_ld(&bar[XB_TOPGEN]) == tg, bar);
            __builtin_amdgcn_fence(__ATOMIC_ACQUIRE, "agent");
            xb_add(&bar[XB_XGEN(b.x)], 1u);
            asm volatile("s_waitcnt vmcnt(0)" ::: "memory");
        } else {
            XB_SPIN(xb_ld(&bar[XB_XGEN(b.x)]) == gen, bar);
            __builtin_amdgcn_fence(__ATOMIC_ACQUIRE, "agent");
            asm volatile("s_waitcnt vmcnt(0)" ::: "memory");
        }
    }
    __syncthreads();
}

namespace pg8 {
#define PG8_LAS __attribute__((address_space(3)))
typedef unsigned short bf16_t;
typedef short bf16x8 __attribute__((ext_vector_type(8)));
typedef float f32x4 __attribute__((ext_vector_type(4)));
typedef unsigned u32x4 __attribute__((ext_vector_type(4)));
constexpr int BM = 256, BK = 64, HALF = 128, HTB = HALF * BK * 2  , STAGE_BYTES = 8 * HTB, NXCD = 8, WGM = 8;

__host__ __device__ __forceinline__ int lds_byte(int r, int c) { const int st = (r >> 4) * 2 + (c >> 5), rr = r & 15, cc = c & 31, ob = rr * 64 + cc * 2; return st * 1024 + (ob ^ (((ob >> 9) & 1) << 5)); }
__host__ __device__ __forceinline__ void stage_rc(int b, int& R, int& C) { const int st = b / 1024, sb = b % 1024, swz = sb ^ (((sb >> 9) & 1) << 5); R = (st >> 1) * 16 + swz / 64; C = (st & 1) * 32 + (swz % 64) / 2; }
__host__ __device__ __forceinline__ int perm32(int rho) { const int n = rho >> 4, i = rho & 15; return 8 * (i >> 2) + 4 * n + (i & 3); }

struct Unit { int pm, pn; };
struct Gemm { const bf16_t* A; const bf16_t* Bt; int M, N, K, lda, ldb; };

struct StaticOrder {
    int nM, nN, nwg, G, c;
    __host__ __device__ void init(int M, int N, int G_, int c_) { nM = M / BM; nN = N / BM; nwg = nM * nN; G = G_; c = c_; }
    __host__ __device__ bool next(int i, Unit& u) const {
        const long L = (long)i * G + c; if (L >= nwg) return false;
        int wgid = (int)L; { const int q = nwg / NXCD, r = nwg % NXCD, xcd = wgid % NXCD, off = wgid / NXCD; wgid = (xcd < r ? xcd * (q + 1) : r * (q + 1) + (xcd - r) * q) + off; }
        const int nig = WGM * nN, gid = wgid / nig, fm = gid * WGM, gsz = (nM - fm) < WGM ? (nM - fm) : WGM;
        u.pm = fm + ((wgid % nig) % gsz); u.pn = (wgid % nig) / gsz; return true;
    }
    __device__ __forceinline__ void a_ready(const Unit&) const {}
    __device__ __forceinline__ void done(const Unit&) const {}
};
struct Gemm1Order {
    StaticOrder a, b; int G, c;
    __host__ __device__ void init(int G_, int c_) { G = G_; c = c_; a.init(32768, 1792, G_, 0); b.init(768, 32768, G_, 0); }
    __host__ __device__ bool next(int i, Unit& u) const {
        const long L = (long)i * G + c;
        if (L < a.nwg) { StaticOrder t = a; t.G = 1; t.c = 0; return t.next((int)L, u); }
        if (L < a.nwg + b.nwg) { StaticOrder t = b; t.G = 1; t.c = 0; t.next((int)(L - a.nwg), u); u.pm += 128; u.pn += 7; return true; }
        return false;
    }
    __device__ __forceinline__ void a_ready(const Unit&) const {}
    __device__ __forceinline__ void done(const Unit&) const {}
};


__device__ __forceinline__ unsigned cvt_pk_bf16(float lo, float hi) { unsigned r; asm volatile("v_cvt_pk_bf16_f32 %0, %1, %2" : "=v"(r) : "v"(lo), "v"(hi)); return r; }
struct EpiQKFrag {
    static constexpr bool PERM = true, AFTER_DRAIN = false;
    bf16_t* O; int Mtok;
    __device__ __forceinline__ void operator()(const f32x4 (&acc)[2][2][4][2], const Unit& u, int wr, int wc, int fr, int fq) const {
        const int row0 = u.pm * BM + wr * 64 + fr, col0 = u.pn * BM + wc * 32 + 8 * fq;
#pragma unroll
        for (int ai = 0; ai < 2; ++ai)
#pragma unroll
            for (int m = 0; m < 4; ++m) { const int row = row0 + ai * HALF + m * 16;
#pragma unroll
                for (int bj = 0; bj < 2; ++bj) { const int c = col0 + bj * HALF, hb = c >> 6, d0 = c & 63;
                    const f32x4 v0 = acc[ai][bj][m][0], v1 = acc[ai][bj][m][1];
                    u32x4 w; w.x = cvt_pk_bf16(v0[0], v0[1]); w.y = cvt_pk_bf16(v0[2], v0[3]); w.z = cvt_pk_bf16(v1[0], v1[1]); w.w = cvt_pk_bf16(v1[2], v1[3]);
                    *(u32x4*)(O + (size_t)hb * Mtok * 64 + (size_t)(row >> 5) * 2048 + (d0 >> 3) * 256 + (row & 31) * 8) = w; } }
    }
};
struct EpiVTFrag {
    static constexpr bool PERM = true, AFTER_DRAIN = false;
    bf16_t* O; int Mtok;
    __device__ __forceinline__ void operator()(const f32x4 (&acc)[2][2][4][2], const Unit& u, int wr, int wc, int fr, int fq) const {
        typedef unsigned u32x2 __attribute__((ext_vector_type(2)));
        const int row0 = u.pm * BM + wr * 64 + fr, col0 = u.pn * BM + wc * 32 + 8 * fq;
#pragma unroll
        for (int ai = 0; ai < 2; ++ai)
#pragma unroll
            for (int m = 0; m < 4; ++m) { const int vrow = row0 + ai * HALF + m * 16, vb = vrow >> 6, dt = (vrow >> 5) & 1, r = vrow & 31;
#pragma unroll
                for (int bj = 0; bj < 2; ++bj) { const int t0 = col0 + bj * HALF, k0 = t0 & 31, sk = k0 >> 4, half = (k0 >> 3) & 1;
                    const f32x4 v0 = acc[ai][bj][m][0], v1 = acc[ai][bj][m][1];
                    bf16_t* base = O + (size_t)vb * Mtok * 64 + (size_t)(t0 >> 5) * 2048 + ((dt * 2 + sk) * 2) * 256 + r * 8 + 4 * half;
                    u32x2 lo, hi; lo.x = cvt_pk_bf16(v0[0], v0[1]); lo.y = cvt_pk_bf16(v0[2], v0[3]); hi.x = cvt_pk_bf16(v1[0], v1[1]); hi.y = cvt_pk_bf16(v1[2], v1[3]);
                    *(u32x2*)(base) = lo;
                    *(u32x2*)(base + 256) = hi; } }
    }
};
struct EpiGemm1 {
    static constexpr bool PERM = true, AFTER_DRAIN = false;
    EpiQKFrag qk; EpiVTFrag vt;
    __device__ __forceinline__ void operator()(const f32x4 (&acc)[2][2][4][2], const Unit& u, int wr, int wc, int fr, int fq) const {
        if (u.pm < 128) qk(acc, u, wr, wc, fr, fq);
        else { Unit v; v.pm = u.pm - 128; v.pn = u.pn - 7; vt(acc, v, wr, wc, fr, fq); }
    }
};
struct EpiResGate {
    static constexpr bool PERM = true, AFTER_DRAIN = false;
    const float* x; const float* ada; bf16_t* out;
    __device__ __forceinline__ void operator()(const f32x4 (&acc)[2][2][4][2], const Unit& u, int wr, int wc, int fr, int fq) const {
        const int row0 = u.pm * BM + wr * 64 + fr, col0 = u.pn * BM + wc * 32 + 8 * fq;
        const float* gate = ada + (size_t)((u.pm * BM) >> 13) * 6144 + 2048;
        f32x4 gv[2][2];
#pragma unroll
        for (int bj = 0; bj < 2; ++bj)
#pragma unroll
            for (int n = 0; n < 2; ++n) gv[bj][n] = *(const f32x4*)(gate + col0 + bj * HALF + 4 * n);
#pragma unroll
        for (int ai = 0; ai < 2; ++ai)
#pragma unroll
            for (int m = 0; m < 4; ++m) { const size_t off = (size_t)(row0 + ai * HALF + m * 16) * 1024 + col0;
#pragma unroll
                for (int bj = 0; bj < 2; ++bj) {
                    const f32x4 x0 = *(const f32x4*)(x + off + bj * HALF), x1 = *(const f32x4*)(x + off + bj * HALF + 4);
                    const f32x4 v0 = x0 + gv[bj][0] * acc[ai][bj][m][0], v1 = x1 + gv[bj][1] * acc[ai][bj][m][1];
                    u32x4 w; w.x = cvt_pk_bf16(v0[0], v0[1]); w.y = cvt_pk_bf16(v0[2], v0[3]); w.z = cvt_pk_bf16(v1[0], v1[1]); w.w = cvt_pk_bf16(v1[2], v1[3]);
                    *(u32x4*)(out + off + bj * HALF) = w; } }
    }
};

template <class Epi, class Sched, bool ALIGN_EPI = false, bool SP2 = false>
__device__ __forceinline__ void gemm_phase(PG8_LAS unsigned char* lds, const Gemm g, const Sched& S, const Epi& E) {
    int tid = threadIdx.x; asm volatile("" : "+v"(tid));
    const int wid = __builtin_amdgcn_readfirstlane(tid >> 6), lane = tid & 63, wr = wid >> 2, wc = wid & 3, fr = lane & 15, fq = lane >> 4;
    const int K = g.K, nt = K / BK;
    unsigned voffA[2], voffB[2];
#pragma unroll
    for (int i = 0; i < 2; ++i) { int R, C; stage_rc(tid * 16 + i * 8192, R, C); const int Rb = Epi::PERM ? ((R & ~31) + perm32(R & 31)) : R;
        voffA[i] = (unsigned)(R * g.lda + C) * 2u; voffB[i] = (unsigned)(Rb * g.ldb + C) * 2u; }
    const size_t kstep = (size_t)(BK * 2);
    const size_t hstepA = (size_t)HALF * g.lda * 2, hstepB = (size_t)HALF * g.ldb * 2;
    const size_t tstepA = 2 * hstepA, tstepB = 2 * hstepB;
    const unsigned ldsw = (unsigned)wid * 1024u;
    const int aoff = lds_byte(wr * 64 + fr, fq * 8), boff = lds_byte(wc * 32 + fr, fq * 8);
#define PG8_SA(b, h) (((b) * 2 + (h)) * HTB)
#define PG8_SB(b, h) ((4 + (b) * 2 + (h)) * HTB)
#define PG8_STAGE(bufoff, gbase, voff) do { _Pragma("unroll") for (int _i = 0; _i < 2; ++_i) \
        __builtin_amdgcn_global_load_lds((const unsigned*)((const char*)(gbase) + (voff)[_i]), (PG8_LAS unsigned*)(lds + (bufoff) + ldsw + _i * 8192), 16, 0, 0); } while (0)
#define PG8_LDA(dst, b, h) do { _Pragma("unroll") for (int m = 0; m < 4; ++m) _Pragma("unroll") for (int k = 0; k < 2; ++k) dst[m][k] = *(const PG8_LAS bf16x8*)(lds + PG8_SA(b, h) + aoff + m * 2048 + k * 1024); } while (0)
#define PG8_LDB(dst, b, h) do { _Pragma("unroll") for (int n = 0; n < 2; ++n) _Pragma("unroll") for (int k = 0; k < 2; ++k) dst[n][k] = *(const PG8_LAS bf16x8*)(lds + PG8_SB(b, h) + boff + n * 2048 + k * 1024); } while (0)
#define PG8_MMA(ai, bj, At, Bt) do { __builtin_amdgcn_s_setprio(1); _Pragma("unroll") for (int m = 0; m < 4; ++m) _Pragma("unroll") for (int n = 0; n < 2; ++n) _Pragma("unroll") for (int k = 0; k < 2; ++k) \
        acc[ai][bj][m][n] = __builtin_amdgcn_mfma_f32_16x16x32_bf16(Bt[n][k], At[m][k], acc[ai][bj][m][n], 0, 0, 0); __builtin_amdgcn_s_setprio(0); } while (0)
#define PG8_WAIT_V(n) asm volatile("s_waitcnt vmcnt(" #n ")" ::: "memory")
#define PG8_WAIT_L(n) asm volatile("s_waitcnt lgkmcnt(" #n ")" ::: "memory")
#define PG8_BAR __builtin_amdgcn_s_barrier()
#define PG8_SCHED __builtin_amdgcn_sched_barrier(0)
    Unit cur, nxt; int ui = 0;
    if (!S.next(0, cur)) return;
    f32x4 acc[2][2][4][2];
#pragma unroll
    for (int a = 0; a < 2; ++a)
#pragma unroll
        for (int b = 0; b < 2; ++b)
#pragma unroll
            for (int m = 0; m < 4; ++m)
#pragma unroll
                for (int n = 0; n < 2; ++n) acc[a][b][m][n] = (f32x4){0.f, 0.f, 0.f, 0.f};
    bf16x8 At[4][2], B0[2][2], B1[2][2];
    const char* cA = (const char*)g.A + (size_t)cur.pm * tstepA; const char* cB = (const char*)g.Bt + (size_t)cur.pn * tstepB;
    S.a_ready(cur);
    if constexpr (SP2) {
        PG8_STAGE(PG8_SB(0, 0), cB, voffB); PG8_STAGE(PG8_SB(0, 1), cB + hstepB, voffB); PG8_STAGE(PG8_SA(0, 0), cA, voffA); PG8_STAGE(PG8_SA(0, 1), cA + hstepA, voffA);
        if (wr == 1) PG8_BAR;
        PG8_WAIT_V(2); PG8_BAR;
        PG8_STAGE(PG8_SB(1, 0), cB + kstep, voffB); PG8_STAGE(PG8_SA(1, 0), cA + kstep, voffA); PG8_STAGE(PG8_SB(1, 1), cB + hstepB + kstep, voffB);
        PG8_WAIT_V(6); PG8_BAR;
    } else {
        PG8_STAGE(PG8_SB(0, 0), cB, voffB); PG8_STAGE(PG8_SA(0, 0), cA, voffA); PG8_STAGE(PG8_SB(0, 1), cB + hstepB, voffB); PG8_STAGE(PG8_SA(0, 1), cA + hstepA, voffA);
        if (wr == 1) PG8_BAR;
        PG8_WAIT_V(4); PG8_BAR;
        PG8_STAGE(PG8_SB(1, 0), cB + kstep, voffB); PG8_STAGE(PG8_SA(1, 0), cA + kstep, voffA); PG8_STAGE(PG8_SB(1, 1), cB + hstepB + kstep, voffB);
        PG8_WAIT_V(6); PG8_BAR;
    }
    for (;;) {
        const bool has_next = S.next(ui + 1, nxt);
        const char* nA = has_next ? (const char*)g.A + (size_t)nxt.pm * tstepA : cA; const char* nB = has_next ? (const char*)g.Bt + (size_t)nxt.pn * tstepB : cB;
        for (int t = 0; t < nt; t += 2) {
            const bool last = (t == nt - 2);
            const char* a1 = cA + (size_t)(t + 1) * kstep;
            const char* a2 = last ? nA : cA + (size_t)(t + 2) * kstep; const char* b2 = last ? nB : cB + (size_t)(t + 2) * kstep;
            const char* a3 = a2 + kstep; const char* b3 = b2 + kstep;
            if (last && has_next) S.a_ready(nxt);
            if constexpr (SP2) {
            PG8_LDB(B0, 0, 0); PG8_LDB(B1, 0, 1); PG8_SCHED; PG8_LDA(At, 0, 0); PG8_STAGE(PG8_SA(1, 1), a1 + hstepA, voffA);
            PG8_WAIT_V(8); PG8_WAIT_L(0); PG8_BAR; PG8_MMA(0, 0, At, B0); PG8_MMA(0, 1, At, B1); PG8_BAR; PG8_SCHED;
            PG8_LDA(At, 0, 1); PG8_STAGE(PG8_SB(0, 0), b2, voffB); PG8_STAGE(PG8_SB(0, 1), b2 + hstepB, voffB); PG8_STAGE(PG8_SA(0, 0), a2, voffA);
            PG8_WAIT_V(8); PG8_WAIT_L(0); PG8_BAR; PG8_MMA(1, 0, At, B0); PG8_MMA(1, 1, At, B1); PG8_BAR; PG8_SCHED;
            PG8_LDB(B0, 1, 0); PG8_LDB(B1, 1, 1); PG8_SCHED; PG8_LDA(At, 1, 0); PG8_STAGE(PG8_SA(0, 1), a2 + hstepA, voffA);
            PG8_WAIT_V(8); PG8_WAIT_L(0); PG8_BAR; PG8_MMA(0, 0, At, B0); PG8_MMA(0, 1, At, B1); PG8_BAR; PG8_SCHED;
            PG8_LDA(At, 1, 1); PG8_STAGE(PG8_SB(1, 0), b3, voffB); PG8_STAGE(PG8_SB(1, 1), b3 + hstepB, voffB); PG8_STAGE(PG8_SA(1, 0), a3, voffA);
            PG8_WAIT_V(8); PG8_WAIT_L(0); PG8_BAR; PG8_MMA(1, 0, At, B0); PG8_MMA(1, 1, At, B1); PG8_BAR; PG8_SCHED;
            } else {
            PG8_LDB(B0, 0, 0); PG8_SCHED; PG8_LDA(At, 0, 0); PG8_STAGE(PG8_SA(1, 1), a1 + hstepA, voffA);
            PG8_WAIT_L(8); PG8_BAR; PG8_WAIT_L(0); PG8_MMA(0, 0, At, B0); PG8_BAR; PG8_SCHED;
            PG8_LDB(B1, 0, 1); PG8_STAGE(PG8_SB(0, 0), b2, voffB);
            PG8_BAR; PG8_WAIT_L(0); PG8_MMA(0, 1, At, B1); PG8_BAR;
            PG8_LDA(At, 0, 1); PG8_STAGE(PG8_SA(0, 0), a2, voffA);
            PG8_BAR; PG8_WAIT_L(0); PG8_MMA(1, 0, At, B0); PG8_BAR; PG8_SCHED;
            PG8_STAGE(PG8_SB(0, 1), b2 + hstepB, voffB);
            PG8_WAIT_V(6); PG8_BAR; PG8_MMA(1, 1, At, B1); PG8_BAR;
            PG8_LDB(B0, 1, 0); PG8_SCHED; PG8_LDA(At, 1, 0); PG8_STAGE(PG8_SA(0, 1), a2 + hstepA, voffA);
            PG8_WAIT_L(8); PG8_BAR; PG8_WAIT_L(0); PG8_MMA(0, 0, At, B0); PG8_BAR; PG8_SCHED;
            PG8_LDB(B1, 1, 1); PG8_STAGE(PG8_SB(1, 0), b3, voffB);
            PG8_BAR; PG8_WAIT_L(0); PG8_MMA(0, 1, At, B1); PG8_BAR;
            PG8_LDA(At, 1, 1); PG8_STAGE(PG8_SA(1, 0), a3, voffA);
            PG8_BAR; PG8_WAIT_L(0); PG8_MMA(1, 0, At, B0); PG8_BAR; PG8_SCHED;
            PG8_STAGE(PG8_SB(1, 1), b3 + hstepB, voffB);
            PG8_WAIT_V(6); PG8_BAR; PG8_MMA(1, 1, At, B1); PG8_BAR;
            }
        }
        if constexpr (ALIGN_EPI) { if (wr == 0) PG8_BAR; }
        if constexpr (!Epi::AFTER_DRAIN) { E(acc, cur, wr, wc, fr, fq); S.done(cur); }
        if (!has_next) break;
#pragma unroll
        for (int a = 0; a < 2; ++a)
#pragma unroll
            for (int b = 0; b < 2; ++b)
#pragma unroll
                for (int m = 0; m < 4; ++m)
#pragma unroll
                    for (int n = 0; n < 2; ++n) acc[a][b][m][n] = (f32x4){0.f, 0.f, 0.f, 0.f};
        cur = nxt; cA = nA; cB = nB; ++ui;
        if constexpr (ALIGN_EPI) { if (wr == 1) PG8_BAR; }
    }
    PG8_WAIT_V(0);
    if constexpr (!ALIGN_EPI) { if (wr == 0) PG8_BAR; }
    PG8_BAR;
    if constexpr (Epi::AFTER_DRAIN) { E.fused(acc, cur, wr, wc, fr, fq, lds, wid, lane); S.done(cur); }
#undef PG8_SA
#undef PG8_SB
#undef PG8_STAGE
#undef PG8_LDA
#undef PG8_LDB
#undef PG8_MMA
#undef PG8_WAIT_V
#undef PG8_WAIT_L
#undef PG8_BAR
#undef PG8_SCHED
}
}

struct Args { const float* in[18]; float* out; unsigned char* ws; };
struct Frame {
    LAS unsigned char* lds;
    int tid, lane, wave, G, bx, gw, ngw;
    const float *x, *c, *w_ada, *b_ada, *g1, *w_in, *sink, *t5, *rpb, *gna, *gnb, *w_out, *g2, *w_query, *sub_keys, *uexp, *vexp, *gfin;
    float* out; float* ada;
    bf16 *WO, *WQ, *SK, *W1A, *H, *WVT, *PROJ, *VT, *QP, *MIX;
    unsigned char *U8, *V8, *X8; float *SU, *SV, *SX; unsigned* ctl; volatile LAS unsigned* MISC; bf16* X1;
    int* IDX; float* GT;
};

__device__ __forceinline__ void p0_transpose_item(const float* W, int N, bf16* WT, int K, int k0, int n0, int dst_row0, float scale, LAS float* scr, int lane) {
#pragma unroll 8
    for (int i = 0; i < 32; ++i) { const int kk = 2 * i + (lane >> 5); scr[kk * 33 + (lane & 31)] = W[(size_t)(k0 + kk) * N + n0 + (lane & 31)] * scale; }
    LDS_WAIT(); asm volatile("" ::: "memory");
    const int c = lane & 7;
#pragma unroll
    for (int j = 0; j < 4; ++j) { const int n = (lane >> 3) + 8 * j; const LAS float* s = scr + (8 * c) * 33 + n;
        v4u o; o.x = pk2(s[0 * 33], s[1 * 33]); o.y = pk2(s[2 * 33], s[3 * 33]); o.z = pk2(s[4 * 33], s[5 * 33]); o.w = pk2(s[6 * 33], s[7 * 33]);
        *(v4u*)(WT + (size_t)(dst_row0 + n) * K + k0 + 8 * c) = o; }
    LDS_WAIT(); asm volatile("" ::: "memory");
}

__device__ __forceinline__ void p0_prologue(Frame& F) {
    {
        LAS float* sc = (LAS float*)F.lds;
        LAS float* red = (LAS float*)(F.lds + 16384);
        for (int i = F.tid; i < 4096; i += NTHREADS) { const float cv = F.c[i]; sc[i] = cv / (1.0f + __expf(-cv)); }
        __syncthreads();
        for (int item = F.bx; item < 96; item += F.G) {
            const int j = item * 64 + F.lane;
            float a0 = 0.f, a1 = 0.f, a2 = 0.f, a3 = 0.f;
            const int i0 = F.wave * 128;
#pragma unroll 4
            for (int i = i0; i < i0 + 128; ++i) {
                const float w = F.w_ada[(size_t)i * 6144 + j];
                a0 += sc[i] * w; a1 += sc[1024 + i] * w; a2 += sc[2048 + i] * w; a3 += sc[3072 + i] * w;
            }
            red[(F.wave * 4 + 0) * 64 + F.lane] = a0; red[(F.wave * 4 + 1) * 64 + F.lane] = a1;
            red[(F.wave * 4 + 2) * 64 + F.lane] = a2; red[(F.wave * 4 + 3) * 64 + F.lane] = a3;
            __syncthreads();
            if (F.wave < 4) {
                float s = F.b_ada[j];
#pragma unroll
                for (int w = 0; w < 8; ++w) s += red[(w * 4 + F.wave) * 64 + F.lane];
                F.ada[F.wave * 6144 + j] = s;
            }
            if (item < 32) {
                asm volatile("s_waitcnt vmcnt(0)" ::: "memory");
                __syncthreads();
                if (F.tid == 0) { __builtin_amdgcn_fence(__ATOMIC_RELEASE, "agent"); asm volatile("s_waitcnt vmcnt(0)" ::: "memory");
                                  __hip_atomic_fetch_add(F.ctl + CW_ADA, 1u, __ATOMIC_RELAXED, __HIP_MEMORY_SCOPE_AGENT); }
            }
            __syncthreads();
        }
        __syncthreads();
    }
    {
        LAS float* scr = (LAS float*)(F.lds + F.wave * 16384);
        constexpr int I_IN = 16 * 72, I_O = 16 * 32, I_Q = 16 * 64;
        for (int it = F.gw; it < I_IN + I_O + I_Q; it += F.ngw) {
            int r = it;
            if (r < I_IN) {
                const int kb = r / 72, nb = r % 72, n0 = 32 * nb;
                bf16* dst; int row0; float scale = 1.0f;
                if (n0 < 512) { dst = F.W1A; row0 = n0; scale = 0.125f * 1.4426950408889634f; }
                else if (n0 < 640) { dst = F.W1A; row0 = n0; }
                else if (n0 < 768) { dst = F.WVT; row0 = n0 - 640; }
                else if (n0 < 1280) { dst = F.W1A; row0 = n0 - 128; scale = 0.125f * 1.4426950408889634f; }
                else if (n0 < 1792) { dst = F.W1A; row0 = n0 - 128; }
                else { dst = F.WVT; row0 = 128 + (n0 - 1792); }
                p0_transpose_item(F.w_in, 2304, dst, D, 64 * kb, n0, row0, scale, scr, F.lane);
                continue;
            }
            r -= I_IN;
            if (r < I_O) { const int kb = r / 32, nb = r % 32; p0_transpose_item(F.w_out, 1024, F.WO, D, 64 * kb, 32 * nb, 32 * nb, 1.0f, scr, F.lane); continue; }
            r -= I_O;
            { const int kb = r / 64, nb = r % 64; p0_transpose_item(F.w_query, 2048, F.WQ, D, 64 * kb, 32 * nb, 32 * nb, 1.0f, scr, F.lane); }
        }
    }
    {
        const int gid = F.bx * NTHREADS + F.tid;
        if (gid < 16384) ((v4u*)(F.W1A + (size_t)1664 * D))[gid] = (v4u){0u, 0u, 0u, 0u};
        else if (gid < 32768) ((v4u*)(F.WVT + (size_t)640 * D))[gid - 16384] = (v4u){0u, 0u, 0u, 0u};
    }
    {
        for (int row0 = F.gw; row0 < 2 * NEXP; row0 += 4 * F.ngw) {
            f32x4 a[4][4];
#pragma unroll
            for (int u = 0; u < 4; ++u) { const int row = row0 + u * F.ngw; const bool isv = row >= NEXP; const int rr = isv ? row - NEXP : row;
                const f32x4* src = (const f32x4*)((isv ? F.vexp : F.uexp) + (size_t)rr * D) + 4 * F.lane;
                a[u][0] = src[0]; a[u][1] = src[1]; a[u][2] = src[2]; a[u][3] = src[3]; }
#pragma unroll
            for (int u = 0; u < 4; ++u) { const int row = row0 + u * F.ngw; const bool isv = row >= NEXP; const int rr = isv ? row - NEXP : row;
                float am = 0.f;
#pragma unroll
                for (int q = 0; q < 4; ++q) am = fmaxf(am, fmaxf(fmaxf(fabsf(a[u][q].x), fabsf(a[u][q].y)), fmaxf(fabsf(a[u][q].z), fabsf(a[u][q].w))));
                am = wave_max(am);
                const float inv = am > 0.f ? 127.0f / am : 0.f, scale = am * (1.0f / 127.0f);
                v4u o; o.x = q8x4(a[u][0], inv, 0); o.y = q8x4(a[u][1], inv, 0); o.z = q8x4(a[u][2], inv, 0); o.w = q8x4(a[u][3], inv, 0);
                *(v4u*)((isv ? F.V8 : F.U8) + ((size_t)(F.lane >> 3) * NEXP + rr) * 128 + (F.lane & 7) * 16) = o;
                if (F.lane == 0) (isv ? F.SV : F.SU)[rr] = scale; }
        }
        const size_t gid = (size_t)F.bx * NTHREADS + F.tid, gsz = (size_t)F.G * NTHREADS;
        for (size_t i = gid; i < 32768; i += gsz) {
            const int ln = (int)(i & 63), sk = (int)((i >> 6) & 7), nt = (int)((i >> 9) & 3), hh = (int)(i >> 11);
            const int n = 32 * nt + (ln & 31), d0 = 16 * sk + 8 * (ln >> 5);
            const f32x4* src = (const f32x4*)(F.sub_keys + ((size_t)hh * 128 + n) * 128 + d0);
            const f32x4 a = src[0], b = src[1];
            v4u o; o.x = pk2(a.x, a.y); o.y = pk2(a.z, a.w); o.z = pk2(b.x, b.y); o.w = pk2(b.z, b.w);
            ((v4u*)F.SK)[i] = o;
        }
    }
}

__device__ __forceinline__ void load_mod_vectors(f32x4 (&gs)[4], f32x4 (&sh)[4], const float* g, const float* shift, const float* scale, int lane) {
#pragma unroll
    for (int j = 0; j < 4; ++j) { const f32x4 gg = ((const f32x4*)g)[lane + 64 * j], sc = ((const f32x4*)scale)[lane + 64 * j]; gs[j] = gg * (sc + 1.0f); sh[j] = ((const f32x4*)shift)[lane + 64 * j]; }
}
__device__ __forceinline__ f32x4 load_row4(const float* row, int i4) { return ((const f32x4*)row)[i4]; }
__device__ __forceinline__ f32x4 load_row4(const bf16* row, int i4) { const v2u w = ((const v2u*)row)[i4]; return (f32x4){bflo(w.x), bfhi(w.x), bflo(w.y), bfhi(w.y)}; }
template <bool Q8, class TIN>
__device__ __forceinline__ void norm_mod_row(const TIN* xrow, bf16* orow, const f32x4 (&gs)[4], const f32x4 (&sh)[4], int lane, unsigned char* qrow = nullptr, float* qscale = nullptr) {
    f32x4 v[4]; float ss = 0.f;
#pragma unroll
    for (int j = 0; j < 4; ++j) { v[j] = load_row4(xrow, lane + 64 * j); ss += (v[j].x * v[j].x + v[j].y * v[j].y) + (v[j].z * v[j].z + v[j].w * v[j].w); }
    ss = wave_sum(ss);
    const float rstd = 1.0f / sqrtf(ss * (1.0f / 1024.0f) + EPS);
    unsigned long long* o8 = (unsigned long long*)orow + lane;
    float am = 0.f;
#pragma unroll
    for (int j = 0; j < 4; ++j) {
        const f32x4 y = v[j] * rstd * gs[j] + sh[j];
        o8[64 * j] = (unsigned long long)pk2(y.x, y.y) | ((unsigned long long)pk2(y.z, y.w) << 32);
        if (Q8) { v[j] = y; am = fmaxf(am, fmaxf(fmaxf(fabsf(y.x), fabsf(y.y)), fmaxf(fabsf(y.z), fabsf(y.w)))); }
    }
    if (Q8) {
        am = wave_max(am);
        const float inv = am > 0.f ? 127.0f / am : 0.f;
#pragma unroll
        for (int j = 0; j < 4; ++j) ((unsigned*)qrow)[lane + 64 * j] = q8x4(v[j], inv, 0);
        if (lane == 0) *qscale = am * (1.0f / 127.0f);
    }
}

__device__ __forceinline__ int t5_bucket_rel(int rel) {
    const int n = rel < 0 ? -rel : rel; int v;
    if (n < 8) v = n; else if (n < 12) v = 8; else if (n < 16) v = 9; else if (n < 23) v = 10; else if (n < 32) v = 11;
    else if (n < 46) v = 12; else if (n < 64) v = 13; else if (n < 91) v = 14; else v = 15;
    return (rel > 0 ? 16 : 0) + v;
}
__device__ __forceinline__ bf16x8 pack8(const float* p) {
    v4u w; w.x = pk2(p[0], p[1]); w.y = pk2(p[2], p[3]); w.z = pk2(p[4], p[5]); w.w = pk2(p[6], p[7]);
    return __builtin_bit_cast(bf16x8, w);
}
struct KFrag { bf16x8 k[4]; };
struct VFrag { v4u v[2][2]; };
__device__ __forceinline__ void load_k(KFrag& f, const bf16* blk) {
#pragma unroll
    for (int s = 0; s < 4; ++s) f.k[s] = *(const bf16x8*)(blk + 512 * s);
}
__device__ __forceinline__ void load_v(VFrag& f, const bf16* blk) {
#pragma unroll
    for (int dt = 0; dt < 2; ++dt)
#pragma unroll
        for (int s = 0; s < 2; ++s) f.v[dt][s] = *(const v4u*)(blk + (dt * 2 + s) * 512);
}
__device__ __forceinline__ f32x16 score_tile(const KFrag& kf, const bf16x8 (&qf)[4], f32x16 st) {
#pragma unroll
    for (int s = 0; s < 4; ++s) st = MFMA32(kf.k[s], qf[s], st);
    return st;
}
template <int RANGE>
__device__ __forceinline__ void attn_tile_update(const float (&sv)[16], float& m_run, float& l_run, f32x16 (&o)[2], const VFrag& f) {
    constexpr int LO = RANGE == 2 ? 12 : 0, HI = RANGE == 1 ? 4 : 16;
    float mx = sv[LO];
#pragma unroll
    for (int i = LO + 1; i < HI; ++i) mx = fmaxf(mx, sv[i]);
    mx = xhalf_max(mx);
    const float m_new = fmaxf(m_run, mx);
    const float alpha = __builtin_amdgcn_exp2f(m_run - m_new);
    float p[16]; float ls = 0.f;
#pragma unroll
    for (int i = 0; i < 16; ++i) { if (i >= LO && i < HI) { p[i] = __builtin_amdgcn_exp2f(sv[i] - m_new); ls += p[i]; } else p[i] = 0.f; }
    l_run = l_run * alpha + ls; m_run = m_new;
    if (__builtin_amdgcn_ballot_w64(alpha != 1.0f) != 0ull) {
#pragma unroll
        for (int dt = 0; dt < 2; ++dt)
#pragma unroll
            for (int i = 0; i < 16; ++i) o[dt][i] *= alpha;
    }
    if (RANGE != 2) { const bf16x8 pf0 = pack8(p);
#pragma unroll
        for (int dt = 0; dt < 2; ++dt) o[dt] = MFMA32(__builtin_bit_cast(bf16x8, f.v[dt][0]), pf0, o[dt]); }
    if (RANGE != 1) { const bf16x8 pf1 = pack8(p + 8);
#pragma unroll
        for (int dt = 0; dt < 2; ++dt) o[dt] = MFMA32(__builtin_bit_cast(bf16x8, f.v[dt][1]), pf1, o[dt]); }
}
__device__ __forceinline__ void attn_finalize(Frame& F, f32x16 (&o)[2], float l_run, LAS float* ssq, const float* gain  , bf16* orow  , int head, int r, int h) {
    const float lt = xhalf_sum(l_run);
    const float inv = 1.0f / lt;
    float sq = 0.f;
#pragma unroll
    for (int dt = 0; dt < 2; ++dt)
#pragma unroll
        for (int i = 0; i < 16; ++i) { o[dt][i] *= inv; sq += o[dt][i] * o[dt][i]; }
    sq = xhalf_sum(sq);
    if (h == 0) ssq[head * 32 + r] = sq;
    __syncthreads();
    float tot = 0.f;
#pragma unroll
    for (int hd = 0; hd < 8; ++hd) tot += ssq[hd * 32 + r];
    const float rstd = 1.0f / sqrtf(tot * (1.0f / 512.0f) + EPS);
    __syncthreads();
#pragma unroll
    for (int dt = 0; dt < 2; ++dt)
#pragma unroll
        for (int g = 0; g < 4; ++g) {
            const int d = head * 64 + 32 * dt + 8 * g + 4 * h;
            const f32x4 gv = *(const f32x4*)(gain + d);
            v2u w; w.x = pk2(o[dt][4 * g] * rstd * gv.x, o[dt][4 * g + 1] * rstd * gv.y); w.y = pk2(o[dt][4 * g + 2] * rstd * gv.z, o[dt][4 * g + 3] * rstd * gv.w);
            *(v2u*)(orow + d) = w;
        }
}

__device__ __forceinline__ void attn_finalize2(f32x16 (&o)[2][2], const float (&l_run)[2], LAS float* ssq, const float* gain, bf16* orow, int head0, int r, int h) {
#pragma unroll
    for (int e = 0; e < 2; ++e) {
        const float lt = xhalf_sum(l_run[e]);
        const float inv = 1.0f / lt;
        float sq = 0.f;
#pragma unroll
        for (int dt = 0; dt < 2; ++dt)
#pragma unroll
            for (int i = 0; i < 16; ++i) { o[e][dt][i] *= inv; sq += o[e][dt][i] * o[e][dt][i]; }
        sq = xhalf_sum(sq);
        if (h == 0) ssq[(head0 + e) * 32 + r] = sq;
    }
    __syncthreads();
    float tot = 0.f;
#pragma unroll
    for (int hd = 0; hd < 8; ++hd) tot += ssq[hd * 32 + r];
    const float rstd = 1.0f / sqrtf(tot * (1.0f / 512.0f) + EPS);
    __syncthreads();
#pragma unroll
    for (int e = 0; e < 2; ++e)
#pragma unroll
        for (int dt = 0; dt < 2; ++dt)
#pragma unroll
            for (int g = 0; g < 4; ++g) {
                const int d = (head0 + e) * 64 + 32 * dt + 8 * g + 4 * h;
                const f32x4 gv = *(const f32x4*)(gain + d);
                v2u w; w.x = pk2(o[e][dt][4 * g] * rstd * gv.x, o[e][dt][4 * g + 1] * rstd * gv.y); w.y = pk2(o[e][dt][4 * g + 2] * rstd * gv.z, o[e][dt][4 * g + 3] * rstd * gv.w);
                *(v2u*)(orow + d) = w;
            }
}
__device__ __forceinline__ void attn_phase(Frame& F) {
    constexpr float LOG2E = 1.4426950408889634f;
    LAS float* tb = (LAS float*)F.lds;
    LAS float* rp = (LAS float*)(F.lds + 11264);
    LAS float* ssq = (LAS float*)(F.lds + 11264 + 61440);
    for (int i = F.tid; i < 8 * 352; i += NTHREADS) { const int hd = i / 352, rel = i % 352 - 160; tb[i] = (rel >= -128 && rel <= 128) ? F.t5[t5_bucket_rel(rel) * 8 + hd] * LOG2E : -1e30f; }
    for (int i = F.tid; i < 8 * 15 * 128; i += NTHREADS) { const int co = (i & 127) - 48, hr = i >> 7; rp[i] = (co >= 0 && co <= 30) ? F.rpb[hr * 31 + co] * LOG2E : 0.f; }
    __syncthreads();
    const int head = F.wave, kvh = head >> 2, r = F.lane & 31, h = F.lane >> 5;
    const int vcu = (F.G % 8 == 0) ? (F.bx % 8) * (F.G / 8) + F.bx / 8 : F.bx;
    for (int unit = vcu; unit < 1024; unit += F.G) {
        const int b = unit >> 8, q0 = (unit & 255) * 32;
        const int qtile = (b * S + q0) >> 5;
        const bf16* qblk = F.PROJ + (size_t)head * M * 64 + (size_t)qtile * 2048 + F.lane * 8;
        bf16x8 qf[4];
#pragma unroll
        for (int s = 0; s < 4; ++s) qf[s] = *(const bf16x8*)(qblk + 512 * s);
        float m_run = F.sink[head] * LOG2E, l_run = (h == 0) ? 1.0f : 0.0f;
        f32x16 o[2];
#pragma unroll
        for (int dt = 0; dt < 2; ++dt)
#pragma unroll
            for (int i = 0; i < 16; ++i) o[dt][i] = 0.f;
        const int kt_lo = (q0 >= 128) ? -4 : -(q0 >> 5), kt_hi = (q0 + 32 + 128 <= S) ? 4 : ((S - 32 - q0) >> 5);
        const bf16* kbase = F.PROJ + (size_t)(8 + kvh) * M * 64 + (size_t)qtile * 2048 + F.lane * 8;
        const bf16* vbase = F.VT + (size_t)kvh * M * 64 + (size_t)qtile * 2048 + F.lane * 8;
        f32x16 st;
        const LAS float* tbl0 = tb + head * 352 + 160 - r + 4 * h;
        { KFrag k0; load_k(k0, kbase + (ptrdiff_t)kt_lo * 2048); f32x16 ini;
#pragma unroll
          for (int i = 0; i < 16; ++i) ini[i] = tbl0[32 * kt_lo + (i & 3) + 8 * (i >> 2)];
          st = score_tile(k0, qf, ini); }
        for (int kt = kt_lo; kt <= kt_hi; ++kt) {
            const int ktn = kt < kt_hi ? kt + 1 : kt;
            KFrag kn; VFrag vc;
            load_k(kn, kbase + (ptrdiff_t)ktn * 2048);
            load_v(vc, vbase + (ptrdiff_t)kt * 2048);
            f32x16 ini;
#pragma unroll
            for (int i = 0; i < 16; ++i) ini[i] = tbl0[32 * ktn + (i & 3) + 8 * (i >> 2)];
            float sv[16];
#pragma unroll
            for (int i = 0; i < 16; ++i) sv[i] = st[i];
            attn_tile_update<0>(sv, m_run, l_run, o, vc);
            st = score_tile(kn, qf, ini);
        }
        attn_finalize(F, o, l_run, ssq, F.gna, F.MIX + (size_t)(b * S + q0 + r) * D, head, r, h);
    }
    for (int unit = vcu; unit < 512; unit += F.G) {
        const int b = unit >> 7, rg = unit & 127;
        const int rs = (rg - 4) < 0 ? 0 : ((rg - 4) > 120 ? 120 : (rg - 4));
        bf16x8 qf[2][4]; unsigned vm[2]; int cq[2];
#pragma unroll
        for (int qh = 0; qh < 2; ++qh) {
            const int c = 32 * qh + r; cq[qh] = c;
            const int cs = (c - 8) < 0 ? 0 : ((c - 8) > 48 ? 48 : (c - 8));
            const bf16* qblk = F.PROJ + (size_t)(10 + head) * M * 64 + (size_t)(b * 256 + rg * 2 + qh) * 2048 + F.lane * 8;
#pragma unroll
            for (int s = 0; s < 4; ++s) qf[qh][s] = *(const bf16x8*)(qblk + 512 * s);
            unsigned m = 0u;
#pragma unroll
            for (int ct = 0; ct < 2; ++ct)
#pragma unroll
                for (int i = 0; i < 16; ++i) { const int kc = ct * 32 + (i & 3) + 8 * (i >> 2) + 4 * h; m |= (kc >= cs && kc < cs + 16) ? (1u << (16 * ct + i)) : 0u; }
            vm[qh] = m;
        }
        float m_run[2] = {-1e30f, -1e30f}, l_run[2] = {0.0f, 0.0f};
        f32x16 o[2][2];
#pragma unroll
        for (int qh = 0; qh < 2; ++qh)
#pragma unroll
            for (int dt = 0; dt < 2; ++dt)
#pragma unroll
                for (int i = 0; i < 16; ++i) o[qh][dt][i] = 0.f;
        const bf16* kbase = F.PROJ + (size_t)(18 + head) * M * 64 + (size_t)(b * 256 + rs * 2) * 2048 + F.lane * 8;
        const bf16* vbase = F.VT + (size_t)(2 + head) * M * 64 + (size_t)(b * 256 + rs * 2) * 2048 + F.lane * 8;
        f32x16 st[2];
#define NB_INIT(dst, qh, kr_, ct_) do { const LAS float* _rp = rp + (head * 15 + ((kr_) - rg + 7)) * 128 + 48 + (ct_) * 32 + 4 * h - cq[qh] + 15; const unsigned _vm = vm[qh] >> (16 * (ct_)); \
            _Pragma("unroll") for (int i = 0; i < 16; ++i) dst[i] = ((_vm >> i) & 1u) ? _rp[(i & 3) + 8 * (i >> 2)] : -1e30f; } while (0)
        { KFrag k0; load_k(k0, kbase); f32x16 i0, i1; NB_INIT(i0, 0, rs, 0); NB_INIT(i1, 1, rs, 0); st[0] = score_tile(k0, qf[0], i0); st[1] = score_tile(k0, qf[1], i1); }
#pragma unroll 1
        for (int kp = 0; kp < 8; ++kp) {
            const int kr = rs + kp;
#pragma unroll
            for (int ct = 0; ct < 2; ++ct) {
                const int kti = 2 * kp + ct;
                const int ktn = kti < 15 ? kti + 1 : kti;
                KFrag kn; VFrag vc;
                load_k(kn, kbase + (size_t)ktn * 2048);
                load_v(vc, vbase + (size_t)kti * 2048);
                f32x16 i0, i1;
                if (ct == 0) { NB_INIT(i0, 0, kr, 1); NB_INIT(i1, 1, kr, 1); } else { NB_INIT(i0, 0, kr + 1, 0); NB_INIT(i1, 1, kr + 1, 0); }
#pragma unroll
                for (int qh = 0; qh < 2; ++qh) {
                    float sv[16];
#pragma unroll
                    for (int i = 0; i < 16; ++i) sv[i] = st[qh][i];
                    if (qh == 0 && ct == 1) attn_tile_update<1>(sv, m_run[qh], l_run[qh], o[qh], vc);
                    else if (qh == 1 && ct == 0) attn_tile_update<2>(sv, m_run[qh], l_run[qh], o[qh], vc);
                    else attn_tile_update<0>(sv, m_run[qh], l_run[qh], o[qh], vc);
                }
                st[0] = score_tile(kn, qf[0], i0); st[1] = score_tile(kn, qf[1], i1);
            }
        }
#undef NB_INIT
#pragma unroll
        for (int qh = 0; qh < 2; ++qh)
            attn_finalize(F, o[qh], l_run[qh], ssq, F.gnb, F.MIX + (size_t)(b * S + rg * 64 + cq[qh]) * D + 512, head, r, h);
    }
}

__device__ __forceinline__ float tag_f(float v, unsigned tag, unsigned mask) { return __builtin_bit_cast(float, (__builtin_bit_cast(unsigned, v) & ~mask) | tag); }
#define CEX(a, b) do { const float _hi = fmaxf(a, b), _lo = fminf(a, b); a = _hi; b = _lo; } while (0)
template <int N> __device__ __forceinline__ void bitonic_sort_desc(float (&v)[N]) {
#pragma unroll
    for (int k = 2; k <= N; k <<= 1)
#pragma unroll
        for (int j = k >> 1; j > 0; j >>= 1)
#pragma unroll
            for (int i = 0; i < N; ++i) {
                const int l = i ^ j;
                if (l > i) { if ((i & k) == 0) { CEX(v[i], v[l]); } else { CEX(v[l], v[i]); } }
            }
}
__device__ __forceinline__ void bitonic_merge16_desc(float (&v)[16]) {
#pragma unroll
    for (int j = 8; j > 0; j >>= 1)
#pragma unroll
        for (int i = 0; i < 16; ++i) { const int l = i ^ j; if (l > i) CEX(v[i], v[l]); }
}
__device__ __forceinline__ void top16_merge(float (&a)[16], const float (&b)[16]) {
#pragma unroll
    for (int i = 0; i < 16; ++i) a[i] = fmaxf(a[i], b[15 - i]);
    bitonic_merge16_desc(a);
}
__device__ __forceinline__ void top16_pair(const f32x16 (&st)[4], int h, float (&out)[16]) {
    float g[4][16];
#pragma unroll
    for (int nt = 0; nt < 4; ++nt) {
#pragma unroll
        for (int i = 0; i < 16; ++i) g[nt][i] = tag_f(st[nt][i], (unsigned)(32 * nt + crow(i, h)), 127u);
        bitonic_sort_desc<16>(g[nt]);
    }
    top16_merge(g[0], g[1]); top16_merge(g[2], g[3]); top16_merge(g[0], g[2]);
    float th[16];
#pragma unroll
    for (int i = 0; i < 16; ++i) halves(g[0][i], out[i], th[i]);
    top16_merge(out, th);
}

__device__ __forceinline__ void route_phase(Frame& F) {
    const int r = F.lane & 31, h = F.lane >> 5;
    const int head = F.bx & 7;
    for (int i = F.tid; i < 4096; i += NTHREADS) ((LAS v4u*)F.lds)[i] = ((const v4u*)(F.SK + (size_t)head * 2 * 128 * 128))[i];
    __syncthreads();
    LAS int* scr = (LAS int*)(F.lds + 65536 + F.wave * 8192) + F.lane;
    for (int tg = F.bx >> 3; tg < 128; tg += F.G >> 3) {
        const int t0 = (tg * 8 + F.wave) * 32;
        float lst[2][16];
#pragma unroll
        for (int half = 0; half < 2; ++half) {
            const bf16* qblk = F.QP + (size_t)(head * 4 + half * 2) * M * 64 + (size_t)(t0 >> 5) * 2048 + F.lane * 8;
            bf16x8 qf[8];
#pragma unroll
            for (int s = 0; s < 8; ++s) qf[s] = *(const bf16x8*)(qblk + (size_t)(s >> 2) * M * 64 + (s & 3) * 512);
            const LAS unsigned char* sk = F.lds + half * 32768 + F.lane * 16;
            f32x16 st[4];
#pragma unroll
            for (int nt = 0; nt < 4; ++nt) {
#pragma unroll
                for (int i = 0; i < 16; ++i) st[nt][i] = 0.f;
#pragma unroll
                for (int s = 0; s < 8; ++s) st[nt] = MFMA32(*(const LAS bf16x8*)(sk + (nt * 8 + s) * 1024), qf[s], st[nt]);
                __builtin_amdgcn_sched_barrier(0);
            }
            top16_pair(st, h, lst[half]);
            __builtin_amdgcn_sched_barrier(0);
        }
#pragma unroll
        for (int i = 0; i < 16; ++i) { scr[i * 64] = (int)(__builtin_bit_cast(unsigned, lst[0][i]) & 127u); scr[(16 + i) * 64] = (int)(__builtin_bit_cast(unsigned, lst[1][i]) & 127u); }
        constexpr float NEGINF = -3.0e38f;
        float win[16], tmp[16];
#pragma unroll
        for (int j = 0; j < 16; ++j) win[j] = tag_f(lst[0][0] + lst[1][j], (unsigned)j, 255u);
#pragma unroll
        for (int i = 1; i < 8; ++i) {
#pragma unroll
            for (int j = 0; j < 16; ++j) tmp[j] = ((i + 1) * (j + 1) <= 16) ? tag_f(lst[0][i] + lst[1][j], (unsigned)(i * 16 + j), 255u) : NEGINF;
            top16_merge(win, tmp);
        }
#pragma unroll
        for (int j = 0; j < 16; ++j) tmp[j] = (j < 8) ? tag_f(lst[0][8 + j] + lst[1][0], (unsigned)((8 + j) * 16), 255u) : NEGINF;
        top16_merge(win, tmp);
        float e[16]; float es = 0.f;
#pragma unroll
        for (int k = 0; k < 16; ++k) { e[k] = __expf(win[k] - win[0]); es += e[k]; }
        const float einv = 1.0f / es;
        LDS_WAIT(); asm volatile("" ::: "memory");
        int ex[16];
#pragma unroll
        for (int k = 0; k < 16; ++k) { const unsigned code = __builtin_bit_cast(unsigned, win[k]) & 255u; ex[k] = scr[(code >> 4) * 64] * 128 + scr[(16 + (code & 15u)) * 64]; }
        if (h == 0) {
            int* ip = F.IDX + (size_t)(t0 + r) * 128 + head * 16; float* gp = F.GT + (size_t)(t0 + r) * 128 + head * 16;
#pragma unroll
            for (int k4 = 0; k4 < 4; ++k4) {
                *(v4u*)(ip + 4 * k4) = (v4u){(unsigned)ex[4 * k4], (unsigned)ex[4 * k4 + 1], (unsigned)ex[4 * k4 + 2], (unsigned)ex[4 * k4 + 3]};
                *(f32x4*)(gp + 4 * k4) = (f32x4){e[4 * k4] * einv, e[4 * k4 + 1] * einv, e[4 * k4 + 2] * einv, e[4 * k4 + 3] * einv};
            }
        }
        LDS_WAIT(); asm volatile("" ::: "memory");
    }
}

__device__ __forceinline__ float gelu_tanh(float z) {
    const float u = 0.7978845608028654f * (z + 0.044715f * z * z * z);
    const float t = 1.0f - 2.0f / (__expf(2.0f * u) + 1.0f);
    return 0.5f * z * (1.0f + t);
}
__device__ __forceinline__ int rev4(int k) { return ((k & 1) << 3) | ((k & 2) << 1) | ((k & 4) >> 1) | ((k & 8) >> 3); }
__device__ __forceinline__ int idot16(const v4u& a, const v4u& b) {
    int r = __builtin_amdgcn_sdot4((int)a.x, (int)b.x, 0, false); r = __builtin_amdgcn_sdot4((int)a.y, (int)b.y, r, false);
    r = __builtin_amdgcn_sdot4((int)a.z, (int)b.z, r, false); return __builtin_amdgcn_sdot4((int)a.w, (int)b.w, r, false);
}
__device__ __forceinline__ void fma4u(float (&acc)[16], int o, unsigned w, float a) {
    acc[o + 0] += a * (float)(w & 0xffu); acc[o + 1] += a * (float)((w >> 8) & 0xffu); acc[o + 2] += a * (float)((w >> 16) & 0xffu); acc[o + 3] += a * (float)(w >> 24);
}
constexpr int MB_IDX_PITCH = 528, MB_AUX_OFF = 8 * 528, MB_AUX_PITCH = 144, MB_BYTES = 6144;
struct VMeta { v4u n[4]; v4u a; };
__device__ __forceinline__ void v_gather(v4u (&vq)[16], const VMeta& m, const unsigned char* vbase, unsigned c16) {
#pragma unroll
    for (int i = 0; i < 16; ++i) vq[i] = *(const v4u*)(vbase + (unsigned)(m.n[i >> 2][i & 3] * 128u + c16));
}
__device__ __forceinline__ void v_accumulate(int (&acc)[16], const v4u (&vq)[16], const v4u al) {
#pragma unroll
    for (int a = 0; a < 4; ++a)
#pragma unroll
        for (int b = 0; b < 4; ++b) {
            const unsigned r0 = vq[4 * a + 0][b], r1 = vq[4 * a + 1][b], r2 = vq[4 * a + 2][b], r3 = vq[4 * a + 3][b];
            const unsigned t0 = __builtin_amdgcn_perm(r1, r0, 0x05010400u), t1 = __builtin_amdgcn_perm(r1, r0, 0x07030602u);
            const unsigned t2 = __builtin_amdgcn_perm(r3, r2, 0x05010400u), t3 = __builtin_amdgcn_perm(r3, r2, 0x07030602u);
            const unsigned c0 = __builtin_amdgcn_perm(t2, t0, 0x05040100u), c1 = __builtin_amdgcn_perm(t2, t0, 0x07060302u);
            const unsigned c2 = __builtin_amdgcn_perm(t3, t1, 0x05040100u), c3 = __builtin_amdgcn_perm(t3, t1, 0x07060302u);
            acc[4 * b + 0] = __builtin_amdgcn_sdot4((int)c0, (int)al[a], acc[4 * b + 0], false);
            acc[4 * b + 1] = __builtin_amdgcn_sdot4((int)c1, (int)al[a], acc[4 * b + 1], false);
            acc[4 * b + 2] = __builtin_amdgcn_sdot4((int)c2, (int)al[a], acc[4 * b + 2], false);
            acc[4 * b + 3] = __builtin_amdgcn_sdot4((int)c3, (int)al[a], acc[4 * b + 3], false);
        }
}

__device__ __forceinline__ void peer_fused_phase(Frame& F, bf16* pout) {
    const int lane = F.lane, g = lane >> 3, c = lane & 7;
    const bool b0 = c & 1, b1 = c & 2, b2 = c & 4;
    const int i0c = 8 * (c & 1) + 4 * ((c >> 1) & 1) + 2 * ((c >> 2) & 1);
    LAS unsigned char* wl = F.lds + F.wave * 16384;
    constexpr int L_IDX = 0, L_AUXZ = 16 * MB_IDX_PITCH, L_AUXV = L_AUXZ + 2 * 8 * MB_AUX_PITCH;
    const int xcc = (int)(xb_xcc_id() & 7u);
    const int it0 = F.gw * 2;
    const int tkl = lane >> 3, q = lane & 7;
#pragma unroll
    for (int item = 0; item < 2; ++item) {
        const v4u* ip = (const v4u*)(F.IDX + (size_t)((it0 + item) * 8 + tkl) * 128 + 16 * q);
        const v4u a0 = ip[0], a1 = ip[1], a2 = ip[2], a3 = ip[3];
        LAS v4u* p = (LAS v4u*)(wl + L_IDX + (item * 8 + tkl) * MB_IDX_PITCH + q * 64);
        p[0] = a0; p[1] = a1; p[2] = a2; p[3] = a3;
    }
    int zacc[16][2];
#pragma unroll
    for (int i = 0; i < 16; ++i) { zacc[i][0] = 0; zacc[i][1] = 0; }
    {
        int buf = 0;
        { const v4u x0 = *(const v4u*)(F.X8 + (size_t)(it0 * 8 + tkl) * D + xcc * 128 + 16 * q); *(LAS v4u*)(wl + L_AUXZ + tkl * MB_AUX_PITCH + q * 16) = x0; }
#pragma unroll 1
        for (int k = 0; k < 8; ++k) {
            const int s = (xcc + k) & 7, sn = (xcc + k + 1) & 7;
            const unsigned char* ubase = F.U8 + (size_t)s * NEXP * 128;
#pragma unroll
            for (int item = 0; item < 2; ++item) {
                const v4u xn = *(const v4u*)(F.X8 + (size_t)((item == 0 ? it0 + 1 : it0) * 8 + tkl) * D + (item == 0 ? s : sn) * 128 + 16 * q);
                const LAS unsigned char* ib = wl + L_IDX + item * 8 * MB_IDX_PITCH;
                const LAS unsigned char* xb = wl + L_AUXZ + buf * 8 * MB_AUX_PITCH;
#pragma unroll
                for (int tt = 0; tt < 8; ++tt) {
                    const LAS v4u* ip = (const LAS v4u*)(ib + tt * MB_IDX_PITCH + g * 64);
                    const v4u n0 = ip[0], n1 = ip[1], n2 = ip[2], n3 = ip[3];
                    const v4u xq = *(const LAS v4u*)(xb + tt * MB_AUX_PITCH + c * 16);
                    const unsigned e[16] = {n0.x, n0.y, n0.z, n0.w, n1.x, n1.y, n1.z, n1.w, n2.x, n2.y, n2.z, n2.w, n3.x, n3.y, n3.z, n3.w};
                    v4u uq[16];
#pragma unroll
                    for (int i = 0; i < 16; ++i) uq[i] = *(const v4u*)(ubase + (unsigned)(e[i] * 128u + (unsigned)c * 16u));
                    int p[16];
#pragma unroll
                    for (int i = 0; i < 16; ++i) p[i] = idot16(uq[i], xq);
                    int q8_[8], q4_[4], q2_[2];
#pragma unroll
                    for (int i = 0; i < 8; ++i) { const int keep = b0 ? p[8 + i] : p[i], send = b0 ? p[i] : p[8 + i]; q8_[i] = keep + dppi<DPP_XOR1>(send); }
#pragma unroll
                    for (int i = 0; i < 4; ++i) { const int keep = b1 ? q8_[4 + i] : q8_[i], send = b1 ? q8_[i] : q8_[4 + i]; q4_[i] = keep + dppi<DPP_XOR2>(send); }
#pragma unroll
                    for (int i = 0; i < 2; ++i) { const int keep = b2 ? q4_[2 + i] : q4_[i], send = b2 ? q4_[i] : q4_[2 + i]; q2_[i] = keep + __shfl_xor(send, 4); }
                    zacc[item * 8 + tt][0] += q2_[0]; zacc[item * 8 + tt][1] += q2_[1];
                }
                buf ^= 1;
                *(LAS v4u*)(wl + L_AUXZ + buf * 8 * MB_AUX_PITCH + tkl * MB_AUX_PITCH + q * 16) = xn;
                __builtin_amdgcn_sched_barrier(0);
            }
        }
    }
#pragma unroll
    for (int tk = 0; tk < 16; ++tk) {
        const int t = it0 * 8 + tk, j0 = 16 * g + i0c;
        const v2u e = *(const LAS v2u*)(wl + L_IDX + tk * MB_IDX_PITCH + j0 * 4);
        const float* gp = F.GT + (size_t)t * 128 + j0;
        const float sx = F.SX[t];
        const float a0 = gelu_tanh((float)zacc[tk][0] * (sx * F.SU[e.x])) * gp[0] * F.SV[e.x];
        const float a1 = gelu_tanh((float)zacc[tk][1] * (sx * F.SU[e.y])) * gp[1] * F.SV[e.y];
        const float am = wave_max(fmaxf(fabsf(a0), fabsf(a1)));
        const float inv = am > 0.f ? 127.0f / am : 0.f;
        *(LAS unsigned short*)(wl + L_AUXV + tk * MB_AUX_PITCH + j0) = (unsigned short)(q8(a0, inv, 0) | (q8(a1, inv, 0) << 8));
        zacc[tk][0] = __builtin_bit_cast(int, am * (1.0f / 127.0f));
    }
    {
        const int tk = lane >> 3;
        float sa2[2];
#pragma unroll
        for (int item = 0; item < 2; ++item) { float v = 0.f;
#pragma unroll
            for (int j = 0; j < 8; ++j) v = (tk == j) ? __builtin_bit_cast(float, zacc[item * 8 + j][0]) : v;
            sa2[item] = v; }
#pragma unroll 1
        for (int k = 0; k < 8; ++k) {
            const int s = (xcc + k) & 7;
            const unsigned char* vbase = F.V8 + (size_t)s * NEXP * 128;
#pragma unroll
            for (int item = 0; item < 2; ++item) {
                const LAS unsigned char* ib = wl + L_IDX + (item * 8 + tk) * MB_IDX_PITCH;
                const LAS unsigned char* ab = wl + L_AUXV + (item * 8 + tk) * MB_AUX_PITCH;
                const int t = (it0 + item) * 8 + tk;
                int acc[16];
#pragma unroll
                for (int i = 0; i < 16; ++i) acc[i] = 0;
                VMeta mt[2]; v4u vq[2][16];
#pragma unroll
                for (int u = 0; u < 2; ++u) { const LAS v4u* ip = (const LAS v4u*)(ib + u * 64); mt[u].n[0] = ip[0]; mt[u].n[1] = ip[1]; mt[u].n[2] = ip[2]; mt[u].n[3] = ip[3]; mt[u].a = *(const LAS v4u*)(ab + u * 16); }
                v_gather(vq[0], mt[0], vbase, (unsigned)c * 16u);
#pragma unroll
                for (int i = 0; i < 8; ++i) {
                    const int cur = i & 1, nxt = cur ^ 1;
                    const v4u al = mt[cur].a;
                    if (i + 1 < 8) v_gather(vq[nxt], mt[nxt], vbase, (unsigned)c * 16u);
                    if (i + 2 < 8) { const LAS v4u* ip = (const LAS v4u*)(ib + (i + 2) * 64); mt[cur].n[0] = ip[0]; mt[cur].n[1] = ip[1]; mt[cur].n[2] = ip[2]; mt[cur].n[3] = ip[3]; mt[cur].a = *(const LAS v4u*)(ab + (i + 2) * 16); }
                    v_accumulate(acc, vq[cur], al);
                }
                const float sa = sa2[item];
                v4u w0, w1;
                w0.x = pk2(sa * (float)acc[0], sa * (float)acc[1]);   w0.y = pk2(sa * (float)acc[2], sa * (float)acc[3]);
                w0.z = pk2(sa * (float)acc[4], sa * (float)acc[5]);   w0.w = pk2(sa * (float)acc[6], sa * (float)acc[7]);
                w1.x = pk2(sa * (float)acc[8], sa * (float)acc[9]);   w1.y = pk2(sa * (float)acc[10], sa * (float)acc[11]);
                w1.z = pk2(sa * (float)acc[12], sa * (float)acc[13]); w1.w = pk2(sa * (float)acc[14], sa * (float)acc[15]);
                v4u* po = (v4u*)(pout + (size_t)t * D + s * 128 + 16 * c);
                po[0] = w0; po[1] = w1;
                __builtin_amdgcn_sched_barrier(0);
            }
        }
    }
    asm volatile("s_waitcnt vmcnt(0)" ::: "memory");
    {
        int ln = lane; asm volatile("" : "+v"(ln));
        const int tb = it0 * 8;
        const float* gate2 = F.ada + (size_t)(tb >> 13) * 6144 + 5120;
        f32x4 gt[4], gf[4];
#pragma unroll
        for (int j = 0; j < 4; ++j) { gt[j] = ((const f32x4*)gate2)[ln + 64 * j]; gf[j] = ((const f32x4*)F.gfin)[ln + 64 * j]; }
        for (int k = 0; k < 16; k += 2)
#pragma unroll
        for (int u2 = 0; u2 < 2; ++u2) { const int t = tb + k + u2;
            f32x4* xr = (f32x4*)(F.out + (size_t)t * D) + ln;
            const bf16* x1row = F.X1 + (size_t)t * D;
            const v2u* pr = (const v2u*)(pout + (size_t)t * D) + ln;
            f32x4 v[4]; float ss = 0.f;
#pragma unroll
            for (int j = 0; j < 4; ++j) {
                const f32x4 x1 = load_row4(x1row, ln + 64 * j); const v2u pw = pr[64 * j];
                f32x4 y; y.x = x1.x + gt[j].x * bflo(pw.x); y.y = x1.y + gt[j].y * bfhi(pw.x); y.z = x1.z + gt[j].z * bflo(pw.y); y.w = x1.w + gt[j].w * bfhi(pw.y);
                v[j] = y; ss += (y.x * y.x + y.y * y.y) + (y.z * y.z + y.w * y.w);
            }
            ss = wave_sum(ss);
            const float rstd = 1.0f / sqrtf(ss * (1.0f / 1024.0f) + EPS);
#pragma unroll
            for (int j = 0; j < 4; ++j) xr[64 * j] = v[j] * rstd * gf[j];
        }
    }
}

__global__ void __launch_bounds__(NTHREADS, 2) hymba_fwd(Args args) {
    extern __shared__ __attribute__((aligned(16))) unsigned char lds[];
    Frame F;
    F.lds = (LAS unsigned char*)lds;
    F.tid = threadIdx.x; F.lane = F.tid & 63; F.wave = __builtin_amdgcn_readfirstlane(F.tid >> 6);
    F.G = gridDim.x; F.bx = blockIdx.x; F.gw = F.bx * NWAVES + F.wave; F.ngw = F.G * NWAVES;
    unsigned char* ws = args.ws;
    F.x = args.in[0]; F.c = args.in[1]; F.w_ada = args.in[2]; F.b_ada = args.in[3]; F.g1 = args.in[4]; F.w_in = args.in[5]; F.sink = args.in[6]; F.t5 = args.in[7];
    F.rpb = args.in[8]; F.gna = args.in[9]; F.gnb = args.in[10]; F.w_out = args.in[11]; F.g2 = args.in[12]; F.w_query = args.in[13]; F.sub_keys = args.in[14];
    F.uexp = args.in[15]; F.vexp = args.in[16]; F.gfin = args.in[17]; F.out = args.out;
    F.ada = (float*)(ws + WS_ADA); F.WO = (bf16*)(ws + WS_WO); F.WQ = (bf16*)(ws + WS_WQ); F.SK = (bf16*)(ws + WS_SK);
    F.W1A = (bf16*)(ws + WS_W1A); F.H = (bf16*)(ws + WS_H); F.WVT = (bf16*)(ws + WS_WVT); F.U8 = ws + WS_U8; F.V8 = ws + WS_V8; F.X8 = ws + WS_X8; F.SU = (float*)(ws + WS_SU); F.SV = (float*)(ws + WS_SV); F.SX = (float*)(ws + WS_SX); F.ctl = (unsigned*)(ws + WS_CTL); F.X1 = (bf16*)(ws + WS_X1);
    F.PROJ = (bf16*)(ws + WS_PROJ); F.VT = (bf16*)(ws + WS_VT); F.QP = (bf16*)(ws + WS_QP); F.MIX = (bf16*)(ws + WS_MIX); F.IDX = (int*)(ws + WS_IDX); F.GT = (float*)(ws + WS_G);

    volatile LAS unsigned* MISC = (volatile LAS unsigned*)(F.lds + MISC_OFF); F.MISC = MISC;
    if (F.tid < 32) MISC[F.tid] = 0u;
    __syncthreads();
    XcdBarrier bar = xcd_barrier_post((unsigned*)(ws + WS_CTL) + CW_BAR, MISC + 8);

    p0_prologue(F);
    if (F.tid == 0) {
        unsigned sp = 0;
        while (__hip_atomic_load(F.ctl + CW_ADA, __ATOMIC_RELAXED, __HIP_MEMORY_SCOPE_AGENT) < 32u) { __builtin_amdgcn_s_sleep(2); if (++sp > (1u << 22)) break; }
        __builtin_amdgcn_fence(__ATOMIC_ACQUIRE, "agent");
        asm volatile("s_waitcnt vmcnt(0)" ::: "memory");
    }
    __syncthreads();
    {
        const int rpw = M / F.ngw, mb = F.gw * rpw; const float* ad = F.ada + (size_t)(mb >> 13) * 6144;
        int ln = F.lane; asm volatile("" : "+v"(ln));
        f32x4 gs[4], sh[4]; load_mod_vectors(gs, sh, F.g1, ad, ad + 1024, ln);
        for (int k = 0; k < rpw; k += 2) {
#pragma unroll
            for (int u = 0; u < 2; ++u) { const int m = mb + k + u; norm_mod_row<false, float>(F.x + (size_t)m * D, F.H + (size_t)m * D, gs, sh, ln); } }
    }
    xcd_barrier(bar);
    { pg8::Gemm g{F.H, F.W1A, M + NVT, N1A + M, D, D, D}; pg8::Gemm1Order So; So.init(F.G, F.bx);
      pg8::EpiGemm1 E{pg8::EpiQKFrag{F.PROJ, M}, pg8::EpiVTFrag{F.VT, M}};
      pg8::gemm_phase<pg8::EpiGemm1, pg8::Gemm1Order, true, true>(F.lds, g, So, E); }
    xcd_barrier(bar);
    attn_phase(F);
    xcd_barrier(bar);
    { pg8::Gemm g{F.MIX, F.WO, M, D, D, D, D}; pg8::StaticOrder So; So.init(M, D, F.G, F.bx); pg8::EpiResGate E{F.x, F.ada, F.X1};
      pg8::gemm_phase<pg8::EpiResGate, pg8::StaticOrder, true, true>(F.lds, g, So, E); }
    xcd_barrier(bar);
    {
        const int rpw = M / F.ngw, mb = F.gw * rpw; const float* ad = F.ada + (size_t)(mb >> 13) * 6144;
        int ln = F.lane; asm volatile("" : "+v"(ln));
        f32x4 gs[4], sh[4]; load_mod_vectors(gs, sh, F.g2, ad + 3072, ad + 4096, ln);
        for (int k = 0; k < rpw; k += 2) {
#pragma unroll
            for (int u = 0; u < 2; ++u) { const int m = mb + k + u; norm_mod_row<true, bf16>(F.X1 + (size_t)m * D, F.H + (size_t)m * D, gs, sh, ln, F.X8 + (size_t)m * D, F.SX + m); } }
    }
    xcd_barrier(bar);
    { pg8::Gemm g{F.H, F.WQ, M, NQ, D, D, D}; pg8::StaticOrder So; So.init(M, NQ, F.G, F.bx); pg8::EpiQKFrag E{F.QP, M};
      pg8::gemm_phase<pg8::EpiQKFrag, pg8::StaticOrder, true, true>(F.lds, g, So, E); }
    xcd_barrier(bar);
    route_phase(F);
    xcd_barrier(bar);
    peer_fused_phase(F, F.MIX);
}

extern "C" void kernel_launch(void* const* d_in, const int* in_sizes, int n_in, void* d_out, int out_size, void* d_ws, size_t ws_size, hipStream_t stream) {
    static int grid = 0;
    if (grid == 0) {
        if (n_in != 18 || out_size != M * D || ws_size < WS_END) { fprintf(stderr, "kernel_launch: unexpected shapes (n_in %d out %d ws %zu)\n", n_in, out_size, ws_size); grid = -1; return; }
        int dev = 0, cus = 0, per_cu = 0;
        if (hipGetDevice(&dev) != hipSuccess || hipDeviceGetAttribute(&cus, hipDeviceAttributeMultiprocessorCount, dev) != hipSuccess) { grid = -1; return; }
        if (hipFuncSetAttribute((const void*)hymba_fwd, hipFuncAttributeMaxDynamicSharedMemorySize, LDS_BYTES) != hipSuccess) { fprintf(stderr, "kernel_launch: hipFuncSetAttribute failed\n"); grid = -1; return; }
        if (hipOccupancyMaxActiveBlocksPerMultiprocessor(&per_cu, (const void*)hymba_fwd, NTHREADS, LDS_BYTES) != hipSuccess || per_cu < 1) { fprintf(stderr, "kernel_launch: occupancy query says %d\n", per_cu); per_cu = 1; }
        (void)hipGetLastError();
        grid = cus;
    }
    if (grid < 0) return;
    if (hipMemsetAsync((char*)d_ws + WS_CTL, 0, CTL_ZERO_BYTES, stream) != hipSuccess) return;
    Args a{};
    for (int i = 0; i < 18; ++i) a.in[i] = (const float*)d_in[i];
    a.out = (float*)d_out; a.ws = (unsigned char*)d_ws;
    hipLaunchKernelGGL(hymba_fwd, dim3(grid), dim3(NTHREADS), LDS_BYTES, stream, a);
}
```

```cpp
#include <hip/hip_runtime.h>
#include <cstdio>
#include <cstdint>

#define GAS __attribute__((address_space(1)))
#define LAS __attribute__((address_space(3)))
typedef unsigned short bf16;
typedef unsigned v4u __attribute__((ext_vector_type(4)));
typedef unsigned v2u __attribute__((ext_vector_type(2)));
typedef float f32x4 __attribute__((ext_vector_type(4)));
typedef float f32x16 __attribute__((ext_vector_type(16)));
typedef short bf16x8 __attribute__((ext_vector_type(8)));
typedef __bf16 bf16x2v __attribute__((ext_vector_type(2)));

#define MFMA32(a, b, c) __builtin_amdgcn_mfma_f32_32x32x16_bf16((a), (b), (c), 0, 0, 0)
#define LDS_WAIT() asm volatile("s_waitcnt lgkmcnt(0)" ::: "memory")

constexpr int NB = 4, S = 8192, D = 1024, M = NB * S;
constexpr int N1A = 1792;
constexpr int NVT = 768;
constexpr int NQ = 2048;
constexpr int NEXP = 16384;
constexpr float EPS = 1e-6f;
constexpr int NWAVES = 8, NTHREADS = 512;

constexpr size_t MiB = 1u << 20;
constexpr size_t WS_CTL = 0, CTL_ZERO_BYTES = 64 * 1024;
constexpr size_t WS_ADA = 1 * MiB;
constexpr size_t WS_WO = 2 * MiB;
constexpr size_t WS_WQ = 4 * MiB;
constexpr size_t WS_SK = 8 * MiB;
constexpr size_t WS_WBIG = 10 * MiB;
constexpr size_t WS_W1A = WS_WBIG, WS_H = WS_WBIG + (size_t)N1A * D * 2, WS_WVT = WS_H + (size_t)M * D * 2;
constexpr size_t WS_SU = 1 * MiB + 256 * 1024, WS_SV = 1 * MiB + 512 * 1024, WS_SX = 1 * MiB + 768 * 1024;
constexpr size_t WS_U8 = 80 * MiB, WS_V8 = 96 * MiB;
constexpr size_t WS_X8 = 112 * MiB;
constexpr size_t WS_PROJ = 144 * MiB;
constexpr size_t WS_VT = 256 * MiB;
constexpr size_t WS_QP = 144 * MiB;
constexpr size_t WS_MIX = 306 * MiB;
constexpr size_t WS_IDX = 372 * MiB;
constexpr size_t WS_G = 388 * MiB;
constexpr size_t WS_X1 = 416 * MiB;
constexpr size_t WS_END = 480 * MiB;
static_assert(WS_VT + (size_t)NVT * M * 2 <= WS_MIX, "ws map");
static_assert(WS_WVT + (size_t)NVT * D * 2 <= WS_U8 && WS_X8 + (size_t)M * D <= WS_PROJ, "ws map");
static_assert(WS_QP + (size_t)M * NQ * 2 <= WS_MIX, "ws map");
constexpr int CW_BAR = 4096;
constexpr int CW_ADA = 12288;

static_assert((12288 + 64) * 4 <= (int)CTL_ZERO_BYTES && (4096 + 3456) * 4 <= (int)CTL_ZERO_BYTES, "control words inside the per-call memset");
constexpr int LDS_BYTES = 147456;
constexpr int MISC_OFF = 131072 + 320;

typedef float f32x2v __attribute__((ext_vector_type(2)));
__device__ __forceinline__ unsigned pk2(float lo, float hi) { f32x2v v; v.x = lo; v.y = hi; return __builtin_bit_cast(unsigned, __builtin_convertvector(v, bf16x2v)); }
__device__ __forceinline__ float bflo(unsigned w) { return __builtin_bit_cast(float, w << 16); }
__device__ __forceinline__ float bfhi(unsigned w) { return __builtin_bit_cast(float, w & 0xffff0000u); }
constexpr int DPP_XOR1 = 0xB1, DPP_XOR2 = 0x4E, DPP_ROR4 = 0x124, DPP_ROR8 = 0x128;
template <int CTRL> __device__ __forceinline__ float dppf(float x) { return __builtin_bit_cast(float, __builtin_amdgcn_mov_dpp(__builtin_bit_cast(int, x), CTRL, 0xf, 0xf, true)); }
template <int CTRL> __device__ __forceinline__ int dppi(int x) { return __builtin_amdgcn_mov_dpp(x, CTRL, 0xf, 0xf, true); }
__device__ __forceinline__ void halves(float x, float& lo, float& hi) {
    auto t = __builtin_amdgcn_permlane32_swap(__builtin_bit_cast(unsigned, x), __builtin_bit_cast(unsigned, x), false, false);
    const unsigned a = t[0], b = t[1];
    lo = __builtin_bit_cast(float, a); hi = __builtin_bit_cast(float, b);
}
__device__ __forceinline__ float xhalf_max(float x) { float a, b; halves(x, a, b); return fmaxf(a, b); }
__device__ __forceinline__ float xhalf_sum(float x) { float a, b; halves(x, a, b); return a + b; }
__device__ __forceinline__ float wave_sum(float v) {
    v += dppf<DPP_XOR1>(v); v += dppf<DPP_XOR2>(v); v += dppf<DPP_ROR4>(v); v += dppf<DPP_ROR8>(v);
    auto s = __builtin_amdgcn_permlane16_swap(__builtin_bit_cast(unsigned, v), __builtin_bit_cast(unsigned, v), false, false);
    const unsigned s0 = s[0], s1 = s[1];
    v = __builtin_bit_cast(float, s0) + __builtin_bit_cast(float, s1);
    return xhalf_sum(v);
}
__device__ __forceinline__ float wave_max(float v) {
    v = fmaxf(v, dppf<DPP_XOR1>(v)); v = fmaxf(v, dppf<DPP_XOR2>(v)); v = fmaxf(v, dppf<DPP_ROR4>(v)); v = fmaxf(v, dppf<DPP_ROR8>(v));
    auto s = __builtin_amdgcn_permlane16_swap(__builtin_bit_cast(unsigned, v), __builtin_bit_cast(unsigned, v), false, false);
    const unsigned s0 = s[0], s1 = s[1];
    v = fmaxf(__builtin_bit_cast(float, s0), __builtin_bit_cast(float, s1));
    return xhalf_max(v);
}
__device__ __forceinline__ unsigned q8(float v, float inv, int bias) {
    float q = rintf(v * inv); q = fminf(fmaxf(q, -127.f), 127.f);
    return (unsigned)((int)q + bias) & 0xffu;
}
__device__ __forceinline__ unsigned q8x4(const f32x4& v, float inv, int bias) { return q8(v.x, inv, bias) | (q8(v.y, inv, bias) << 8) | (q8(v.z, inv, bias) << 16) | (q8(v.w, inv, bias) << 24); }
__device__ __forceinline__ int crow(int i, int h) { return (i & 3) + 8 * (i >> 2) + 4 * h; }

#define XB_TMO      128
#define XB_XCNT(j)  (256  + 64 * (j))
#define XB_XSUB(j)  (1280 + 64 * (j))
#define XB_XGEN(j)  (2304 + 64 * (j))
#define XB_TOP      3328
#define XB_TOPGEN   3392
#define XCD_BAR_WORDS 3456
#define XB_SPIN_CAP (1u << 18)

__device__ __forceinline__ unsigned xb_ld(unsigned* p)              { return __hip_atomic_load(p, __ATOMIC_RELAXED, __HIP_MEMORY_SCOPE_AGENT); }
__device__ __forceinline__ unsigned xb_add(unsigned* p, unsigned v) { return __hip_atomic_fetch_add(p, v, __ATOMIC_RELAXED, __HIP_MEMORY_SCOPE_AGENT); }
__device__ __forceinline__ unsigned xb_xcc_id() { return (unsigned)__builtin_amdgcn_s_getreg((3 << 11) | 20) & 0xFu; }
#define XB_SPIN(cond, bar) do { unsigned _sp = 0; while (cond) { __builtin_amdgcn_s_sleep(1); \
    if ((++_sp & 255u) == 0u) { if (xb_ld(&(bar)[XB_TMO])) break; if (_sp > XB_SPIN_CAP) { atomicAdd(&(bar)[XB_TMO], 1u); break; } } } } while (0)

struct XcdBarrier {
    unsigned* bar; unsigned x;
    volatile LAS unsigned* st;
};
__device__ __forceinline__ XcdBarrier xcd_barrier_post(unsigned* bar, volatile LAS unsigned* st) {
    XcdBarrier b; b.bar = bar; b.x = xb_xcc_id(); b.st = st;
    if (threadIdx.x == 0) (void)xb_add(&bar[XB_XCNT(b.x)], 1u);
    return b;
}
__device__ __forceinline__ void xcd_barrier_complete(unsigned* bar, unsigned x, unsigned& nloc, unsigned& nx) {
    const unsigned G = gridDim.x * gridDim.y * gridDim.z;
    unsigned sum, cnt, mine, sp = 0u;
    for (;;) {
        sum = 0u; cnt = 0u; mine = 0u;
#pragma unroll
        for (unsigned j = 0; j < 16; ++j) { const unsigned c = xb_ld(&bar[XB_XCNT(j)]); sum += c; cnt += (c > 0u) ? 1u : 0u; mine = (j == x) ? c : mine; }
        if (sum == G) break;
        __builtin_amdgcn_s_sleep(1);
        if ((++sp & 255u) == 0u) { if (xb_ld(&bar[XB_TMO])) break; if (sp > XB_SPIN_CAP) { atomicAdd(&bar[XB_TMO], 1u); break; } }
    }
    nloc = mine > 0u ? mine : 1u; nx = cnt > 0u ? cnt : 1u;
}
__device__ __forceinline__ void xcd_barrier(const XcdBarrier& b) {
    asm volatile("s_waitcnt vmcnt(0)" ::: "memory");
    __syncthreads();
    if (threadIdx.x == 0) {
        unsigned* bar = b.bar;
        __builtin_amdgcn_s_waitcnt(0);
        unsigned nloc = b.st[0], nx = b.st[1];
        if (nloc == 0u) { xcd_barrier_complete(bar, b.x, nloc, nx); b.st[0] = nloc; b.st[1] = nx; }
        const unsigned old = xb_add(&bar[XB_XSUB(b.x)], 1u);
        const unsigned gen = old / nloc;
        if (old + 1u == (gen + 1u) * nloc) {
            __builtin_amdgcn_fence(__ATOMIC_RELEASE, "agent");
            asm volatile("s_waitcnt vmcnt(0)" ::: "memory");
            const unsigned og = xb_add(&bar[XB_TOP], 1u);
            const unsigned tg = og / nx;
            if (og + 1u == (tg + 1u) * nx) xb_add(&bar[XB_TOPGEN], 1u);
            else XB_SPIN(xb_ld(&bar[XB_TOPGEN]) == tg, bar);
            __builtin_amdgcn_fence(__ATOMIC_ACQUIRE, "agent");
            xb_add(&bar[XB_XGEN(b.x)], 1u);
            asm volatile("s_waitcnt vmcnt(0)" ::: "memory");
        } else {
            XB_SPIN(xb_ld(&bar[XB_XGEN(b.x)]) == gen, bar);
            __builtin_amdgcn_fence(__ATOMIC_ACQUIRE, "agent");
            asm volatile("s_waitcnt vmcnt(0)" ::: "memory");
        }
    }
    __syncthreads();
}

namespace pg8 {
#define PG8_LAS __attribute__((address_space(3)))
typedef unsigned short bf16_t;
typedef short bf16x8 __attribute__((ext_vector_type(8)));
typedef float f32x4 __attribute__((ext_vector_type(4)));
typedef unsigned u32x4 __attribute__((ext_vector_type(4)));
constexpr int BM = 256, BK = 64, HALF = 128, HTB = HALF * BK * 2  , STAGE_BYTES = 8 * HTB, NXCD = 8, WGM = 8;

__host__ __device__ __forceinline__ int lds_byte(int r, int c) { const int st = (r >> 4) * 2 + (c >> 5), rr = r & 15, cc = c & 31, ob = rr * 64 + cc * 2; return st * 1024 + (ob ^ (((ob >> 9) & 1) << 5)); }
__host__ __device__ __forceinline__ void stage_rc(int b, int& R, int& C) { const int st = b / 1024, sb = b % 1024, swz = sb ^ (((sb >> 9) & 1) << 5); R = (st >> 1) * 16 + swz / 64; C = (st & 1) * 32 + (swz % 64) / 2; }
__host__ __device__ __forceinline__ int perm32(int rho) { const int n = rho >> 4, i = rho & 15; return 8 * (i >> 2) + 4 * n + (i & 3); }

struct Unit { int pm, pn; };
struct Gemm { const bf16_t* A; const bf16_t* Bt; int M, N, K, lda, ldb; };

struct StaticOrder {
    int nM, nN, nwg, G, c;
    __host__ __device__ void init(int M, int N, int G_, int c_) { nM = M / BM; nN = N / BM; nwg = nM * nN; G = G_; c = c_; }
    __host__ __device__ bool next(int i, Unit& u) const {
        const long L = (long)i * G + c; if (L >= nwg) return false;
        int wgid = (int)L; { const int q = nwg / NXCD, r = nwg % NXCD, xcd = wgid % NXCD, off = wgid / NXCD; wgid = (xcd < r ? xcd * (q + 1) : r * (q + 1) + (xcd - r) * q) + off; }
        const int nig = WGM * nN, gid = wgid / nig, fm = gid * WGM, gsz = (nM - fm) < WGM ? (nM - fm) : WGM;
        u.pm = fm + ((wgid % nig) % gsz); u.pn = (wgid % nig) / gsz; return true;
    }
    __device__ __forceinline__ void a_ready(const Unit&) const {}
    __device__ __forceinline__ void done(const Unit&) const {}
};
struct Gemm1Order {
    StaticOrder a, b; int G, c;
    __host__ __device__ void init(int G_, int c_) { G = G_; c = c_; a.init(32768, 1792, G_, 0); b.init(768, 32768, G_, 0); }
    __host__ __device__ bool next(int i, Unit& u) const {
        const long L = (long)i * G + c;
        if (L < a.nwg) { StaticOrder t = a; t.G = 1; t.c = 0; return t.next((int)L, u); }
        if (L < a.nwg + b.nwg) { StaticOrder t = b; t.G = 1; t.c = 0; t.next((int)(L - a.nwg), u); u.pm += 128; u.pn += 7; return true; }
        return false;
    }
    __device__ __forceinline__ void a_ready(const Unit&) const {}
    __device__ __forceinline__ void done(const Unit&) const {}
};


__device__ __forceinline__ unsigned cvt_pk_bf16(float lo, float hi) { unsigned r; asm volatile("v_cvt_pk_bf16_f32 %0, %1, %2" : "=v"(r) : "v"(lo), "v"(hi)); return r; }
struct EpiQKFrag {
    static constexpr bool PERM = true, AFTER_DRAIN = false;
    bf16_t* O; int Mtok;
    __device__ __forceinline__ void operator()(const f32x4 (&acc)[2][2][4][2], const Unit& u, int wr, int wc, int fr, int fq) const {
        const int row0 = u.pm * BM + wr * 64 + fr, col0 = u.pn * BM + wc * 32 + 8 * fq;
#pragma unroll
        for (int ai = 0; ai < 2; ++ai)
#pragma unroll
            for (int m = 0; m < 4; ++m) { const int row = row0 + ai * HALF + m * 16;
#pragma unroll
                for (int bj = 0; bj < 2; ++bj) { const int c = col0 + bj * HALF, hb = c >> 6, d0 = c & 63;
                    const f32x4 v0 = acc[ai][bj][m][0], v1 = acc[ai][bj][m][1];
                    u32x4 w; w.x = cvt_pk_bf16(v0[0], v0[1]); w.y = cvt_pk_bf16(v0[2], v0[3]); w.z = cvt_pk_bf16(v1[0], v1[1]); w.w = cvt_pk_bf16(v1[2], v1[3]);
                    *(u32x4*)(O + (size_t)hb * Mtok * 64 + (size_t)(row >> 5) * 2048 + (d0 >> 3) * 256 + (row & 31) * 8) = w; } }
    }
};
struct EpiVTFrag {
    static constexpr bool PERM = true, AFTER_DRAIN = false;
    bf16_t* O; int Mtok;
    __device__ __forceinline__ void operator()(const f32x4 (&acc)[2][2][4][2], const Unit& u, int wr, int wc, int fr, int fq) const {
        typedef unsigned u32x2 __attribute__((ext_vector_type(2)));
        const int row0 = u.pm * BM + wr * 64 + fr, col0 = u.pn * BM + wc * 32 + 8 * fq;
#pragma unroll
        for (int ai = 0; ai < 2; ++ai)
#pragma unroll
            for (int m = 0; m < 4; ++m) { const int vrow = row0 + ai * HALF + m * 16, vb = vrow >> 6, dt = (vrow >> 5) & 1, r = vrow & 31;
#pragma unroll
                for (int bj = 0; bj < 2; ++bj) { const int t0 = col0 + bj * HALF, k0 = t0 & 31, sk = k0 >> 4, half = (k0 >> 3) & 1;
                    const f32x4 v0 = acc[ai][bj][m][0], v1 = acc[ai][bj][m][1];
                    bf16_t* base = O + (size_t)vb * Mtok * 64 + (size_t)(t0 >> 5) * 2048 + ((dt * 2 + sk) * 2) * 256 + r * 8 + 4 * half;
                    u32x2 lo, hi; lo.x = cvt_pk_bf16(v0[0], v0[1]); lo.y = cvt_pk_bf16(v0[2], v0[3]); hi.x = cvt_pk_bf16(v1[0], v1[1]); hi.y = cvt_pk_bf16(v1[2], v1[3]);
                    *(u32x2*)(base) = lo;
                    *(u32x2*)(base + 256) = hi; } }
    }
};
struct EpiGemm1 {
    static constexpr bool PERM = true, AFTER_DRAIN = false;
    EpiQKFrag qk; EpiVTFrag vt;
    __device__ __forceinline__ void operator()(const f32x4 (&acc)[2][2][4][2], const Unit& u, int wr, int wc, int fr, int fq) const {
        if (u.pm < 128) qk(acc, u, wr, wc, fr, fq);
        else { Unit v; v.pm = u.pm - 128; v.pn = u.pn - 7; vt(acc, v, wr, wc, fr, fq); }
    }
};
struct EpiResGate {
    static constexpr bool PERM = true, AFTER_DRAIN = false;
    const float* x; const float* ada; bf16_t* out;
    __device__ __forceinline__ void operator()(const f32x4 (&acc)[2][2][4][2], const Unit& u, int wr, int wc, int fr, int fq) const {
        const int row0 = u.pm * BM + wr * 64 + fr, col0 = u.pn * BM + wc * 32 + 8 * fq;
        const float* gate = ada + (size_t)((u.pm * BM) >> 13) * 6144 + 2048;
        f32x4 gv[2][2];
#pragma unroll
        for (int bj = 0; bj < 2; ++bj)
#pragma unroll
            for (int n = 0; n < 2; ++n) gv[bj][n] = *(const f32x4*)(gate + col0 + bj * HALF + 4 * n);
#pragma unroll
        for (int ai = 0; ai < 2; ++ai)
#pragma unroll
            for (int m = 0; m < 4; ++m) { const size_t off = (size_t)(row0 + ai * HALF + m * 16) * 1024 + col0;
#pragma unroll
                for (int bj = 0; bj < 2; ++bj) {
                    const f32x4 x0 = *(const f32x4*)(x + off + bj * HALF), x1 = *(const f32x4*)(x + off + bj * HALF + 4);
                    const f32x4 v0 = x0 + gv[bj][0] * acc[ai][bj][m][0], v1 = x1 + gv[bj][1] * acc[ai][bj][m][1];
                    u32x4 w; w.x = cvt_pk_bf16(v0[0], v0[1]); w.y = cvt_pk_bf16(v0[2], v0[3]); w.z = cvt_pk_bf16(v1[0], v1[1]); w.w = cvt_pk_bf16(v1[2], v1[3]);
                    *(u32x4*)(out + off + bj * HALF) = w; } }
    }
};

template <class Epi, class Sched, bool ALIGN_EPI = false, bool SP2 = false>
__device__ __forceinline__ void gemm_phase(PG8_LAS unsigned char* lds, const Gemm g, const Sched& S, const Epi& E) {
    int tid = threadIdx.x; asm volatile("" : "+v"(tid));
    const int wid = __builtin_amdgcn_readfirstlane(tid >> 6), lane = tid & 63, wr = wid >> 2, wc = wid & 3, fr = lane & 15, fq = lane >> 4;
    const int K = g.K, nt = K / BK;
    unsigned voffA[2], voffB[2];
#pragma unroll
    for (int i = 0; i < 2; ++i) { int R, C; stage_rc(tid * 16 + i * 8192, R, C); const int Rb = Epi::PERM ? ((R & ~31) + perm32(R & 31)) : R;
        voffA[i] = (unsigned)(R * g.lda + C) * 2u; voffB[i] = (unsigned)(Rb * g.ldb + C) * 2u; }
    const size_t kstep = (size_t)(BK * 2);
    const size_t hstepA = (size_t)HALF * g.lda * 2, hstepB = (size_t)HALF * g.ldb * 2;
    const size_t tstepA = 2 * hstepA, tstepB = 2 * hstepB;
    const unsigned ldsw = (unsigned)wid * 1024u;
    const int aoff = lds_byte(wr * 64 + fr, fq * 8), boff = lds_byte(wc * 32 + fr, fq * 8);
#define PG8_SA(b, h) (((b) * 2 + (h)) * HTB)
#define PG8_SB(b, h) ((4 + (b) * 2 + (h)) * HTB)
#define PG8_STAGE(bufoff, gbase, voff) do { _Pragma("unroll") for (int _i = 0; _i < 2; ++_i) \
        __builtin_amdgcn_global_load_lds((const unsigned*)((const char*)(gbase) + (voff)[_i]), (PG8_LAS unsigned*)(lds + (bufoff) + ldsw + _i * 8192), 16, 0, 0); } while (0)
#define PG8_LDA(dst, b, h) do { _Pragma("unroll") for (int m = 0; m < 4; ++m) _Pragma("unroll") for (int k = 0; k < 2; ++k) dst[m][k] = *(const PG8_LAS bf16x8*)(lds + PG8_SA(b, h) + aoff + m * 2048 + k * 1024); } while (0)
#define PG8_LDB(dst, b, h) do { _Pragma("unroll") for (int n = 0; n < 2; ++n) _Pragma("unroll") for (int k = 0; k < 2; ++k) dst[n][k] = *(const PG8_LAS bf16x8*)(lds + PG8_SB(b, h) + boff + n * 2048 + k * 1024); } while (0)
#define PG8_MMA(ai, bj, At, Bt) do { __builtin_amdgcn_s_setprio(1); _Pragma("unroll") for (int m = 0; m < 4; ++m) _Pragma("unroll") for (int n = 0; n < 2; ++n) _Pragma("unroll") for (int k = 0; k < 2; ++k) \
        acc[ai][bj][m][n] = __builtin_amdgcn_mfma_f32_16x16x32_bf16(Bt[n][k], At[m][k], acc[ai][bj][m][n], 0, 0, 0); __builtin_amdgcn_s_setprio(0); } while (0)
#define PG8_WAIT_V(n) asm volatile("s_waitcnt vmcnt(" #n ")" ::: "memory")
#define PG8_WAIT_L(n) asm volatile("s_waitcnt lgkmcnt(" #n ")" ::: "memory")
#define PG8_BAR __builtin_amdgcn_s_barrier()
#define PG8_SCHED __builtin_amdgcn_sched_barrier(0)
    Unit cur, nxt; int ui = 0;
    if (!S.next(0, cur)) return;
    f32x4 acc[2][2][4][2];
#pragma unroll
    for (int a = 0; a < 2; ++a)
#pragma unroll
        for (int b = 0; b < 2; ++b)
#pragma unroll
            for (int m = 0; m < 4; ++m)
#pragma unroll
                for (int n = 0; n < 2; ++n) acc[a][b][m][n] = (f32x4){0.f, 0.f, 0.f, 0.f};
    bf16x8 At[4][2], B0[2][2], B1[2][2];
    const char* cA = (const char*)g.A + (size_t)cur.pm * tstepA; const char* cB = (const char*)g.Bt + (size_t)cur.pn * tstepB;
    S.a_ready(cur);
    if constexpr (SP2) {
        PG8_STAGE(PG8_SB(0, 0), cB, voffB); PG8_STAGE(PG8_SB(0, 1), cB + hstepB, voffB); PG8_STAGE(PG8_SA(0, 0), cA, voffA); PG8_STAGE(PG8_SA(0, 1), cA + hstepA, voffA);
        if (wr == 1) PG8_BAR;
        PG8_WAIT_V(2); PG8_BAR;
        PG8_STAGE(PG8_SB(1, 0), cB + kstep, voffB); PG8_STAGE(PG8_SA(1, 0), cA + kstep, voffA); PG8_STAGE(PG8_SB(1, 1), cB + hstepB + kstep, voffB);
        PG8_WAIT_V(6); PG8_BAR;
    } else {
        PG8_STAGE(PG8_SB(0, 0), cB, voffB); PG8_STAGE(PG8_SA(0, 0), cA, voffA); PG8_STAGE(PG8_SB(0, 1), cB + hstepB, voffB); PG8_STAGE(PG8_SA(0, 1), cA + hstepA, voffA);
        if (wr == 1) PG8_BAR;
        PG8_WAIT_V(4); PG8_BAR;
        PG8_STAGE(PG8_SB(1, 0), cB + kstep, voffB); PG8_STAGE(PG8_SA(1, 0), cA + kstep, voffA); PG8_STAGE(PG8_SB(1, 1), cB + hstepB + kstep, voffB);
        PG8_WAIT_V(6); PG8_BAR;
    }
    for (;;) {
        const bool has_next = S.next(ui + 1, nxt);
        const char* nA = has_next ? (const char*)g.A + (size_t)nxt.pm * tstepA : cA; const char* nB = has_next ? (const char*)g.Bt + (size_t)nxt.pn * tstepB : cB;
        for (int t = 0; t < nt; t += 2) {
            const bool last = (t == nt - 2);
            const char* a1 = cA + (size_t)(t + 1) * kstep;
            const char* a2 = last ? nA : cA + (size_t)(t + 2) * kstep; const char* b2 = last ? nB : cB + (size_t)(t + 2) * kstep;
            const char* a3 = a2 + kstep; const char* b3 = b2 + kstep;
            if (last && has_next) S.a_ready(nxt);
            if constexpr (SP2) {
            PG8_LDB(B0, 0, 0); PG8_LDB(B1, 0, 1); PG8_SCHED; PG8_LDA(At, 0, 0); PG8_STAGE(PG8_SA(1, 1), a1 + hstepA, voffA);
            PG8_WAIT_V(8); PG8_WAIT_L(0); PG8_BAR; PG8_MMA(0, 0, At, B0); PG8_MMA(0, 1, At, B1); PG8_BAR; PG8_SCHED;
            PG8_LDA(At, 0, 1); PG8_STAGE(PG8_SB(0, 0), b2, voffB); PG8_STAGE(PG8_SB(0, 1), b2 + hstepB, voffB); PG8_STAGE(PG8_SA(0, 0), a2, voffA);
            PG8_WAIT_V(8); PG8_WAIT_L(0); PG8_BAR; PG8_MMA(1, 0, At, B0); PG8_MMA(1, 1, At, B1); PG8_BAR; PG8_SCHED;
            PG8_LDB(B0, 1, 0); PG8_LDB(B1, 1, 1); PG8_SCHED; PG8_LDA(At, 1, 0); PG8_STAGE(PG8_SA(0, 1), a2 + hstepA, voffA);
            PG8_WAIT_V(8); PG8_WAIT_L(0); PG8_BAR; PG8_MMA(0, 0, At, B0); PG8_MMA(0, 1, At, B1); PG8_BAR; PG8_SCHED;
            PG8_LDA(At, 1, 1); PG8_STAGE(PG8_SB(1, 0), b3, voffB); PG8_STAGE(PG8_SB(1, 1), b3 + hstepB, voffB); PG8_STAGE(PG8_SA(1, 0), a3, voffA);
            PG8_WAIT_V(8); PG8_WAIT_L(0); PG8_BAR; PG8_MMA(1, 0, At, B0); PG8_MMA(1, 1, At, B1); PG8_BAR; PG8_SCHED;
            } else {
            PG8_LDB(B0, 0, 0); PG8_SCHED; PG8_LDA(At, 0, 0); PG8_STAGE(PG8_SA(1, 1), a1 + hstepA, voffA);
            PG8_WAIT_L(8); PG8_BAR; PG8_WAIT_L(0); PG8_MMA(0, 0, At, B0); PG8_BAR; PG8_SCHED;
            PG8_LDB(B1, 0, 1); PG8_STAGE(PG8_SB(0, 0), b2, voffB);
            PG8_BAR; PG8_WAIT_L(0); PG8_MMA(0, 1, At, B1); PG8_BAR;
            PG8_LDA(At, 0, 1); PG8_STAGE(PG8_SA(0, 0), a2, voffA);
            PG8_BAR; PG8_WAIT_L(0); PG8_MMA(1, 0, At, B0); PG8_BAR; PG8_SCHED;
            PG8_STAGE(PG8_SB(0, 1), b2 + hstepB, voffB);
            PG8_WAIT_V(6); PG8_BAR; PG8_MMA(1, 1, At, B1); PG8_BAR;
            PG8_LDB(B0, 1, 0); PG8_SCHED; PG8_LDA(At, 1, 0); PG8_STAGE(PG8_SA(0, 1), a2 + hstepA, voffA);
            PG8_WAIT_L(8); PG8_BAR; PG8_WAIT_L(0); PG8_MMA(0, 0, At, B0); PG8_BAR; PG8_SCHED;
            PG8_LDB(B1, 1, 1); PG8_STAGE(PG8_SB(1, 0), b3, voffB);
            PG8_BAR; PG8_WAIT_L(0); PG8_MMA(0, 1, At, B1); PG8_BAR;
            PG8_LDA(At, 1, 1); PG8_STAGE(PG8_SA(1, 0), a3, voffA);
            PG8_BAR; PG8_WAIT_L(0); PG8_MMA(1, 0, At, B0); PG8_BAR; PG8_SCHED;
            PG8_STAGE(PG8_SB(1, 1), b3 + hstepB, voffB);
            PG8_WAIT_V(6); PG8_BAR; PG8_MMA(1, 1, At, B1); PG8_BAR;
            }
        }
        if constexpr (ALIGN_EPI) { if (wr == 0) PG8_BAR; }
        if constexpr (!Epi::AFTER_DRAIN) { E(acc, cur, wr, wc, fr, fq); S.done(cur); }
        if (!has_next) break;
#pragma unroll
        for (int a = 0; a < 2; ++a)
#pragma unroll
            for (int b = 0; b < 2; ++b)
#pragma unroll
                for (int m = 0; m < 4; ++m)
#pragma unroll
                    for (int n = 0; n < 2; ++n) acc[a][b][m][n] = (f32x4){0.f, 0.f, 0.f, 0.f};
        cur = nxt; cA = nA; cB = nB; ++ui;
        if constexpr (ALIGN_EPI) { if (wr == 1) PG8_BAR; }
    }
    PG8_WAIT_V(0);
    if constexpr (!ALIGN_EPI) { if (wr == 0) PG8_BAR; }
    PG8_BAR;
    if constexpr (Epi::AFTER_DRAIN) { E.fused(acc, cur, wr, wc, fr, fq, lds, wid, lane); S.done(cur); }
#undef PG8_SA
#undef PG8_SB
#undef PG8_STAGE
#undef PG8_LDA
#undef PG8_LDB
#undef PG8_MMA
#undef PG8_WAIT_V
#undef PG8_WAIT_L
#undef PG8_BAR
#undef PG8_SCHED
}
}

struct Args { const float* in[18]; float* out; unsigned char* ws; };
struct Frame {
    LAS unsigned char* lds;
    int tid, lane, wave, G, bx, gw, ngw;
    const float *x, *c, *w_ada, *b_ada, *g1, *w_in, *sink, *t5, *rpb, *gna, *gnb, *w_out, *g2, *w_query, *sub_keys, *uexp, *vexp, *gfin;
    float* out; float* ada;
    bf16 *WO, *WQ, *SK, *W1A, *H, *WVT, *PROJ, *VT, *QP, *MIX;
    unsigned char *U8, *V8, *X8; float *SU, *SV, *SX; unsigned* ctl; volatile LAS unsigned* MISC; bf16* X1;
    int* IDX; float* GT;
};

__device__ __forceinline__ void p0_transpose_item(const float* W, int N, bf16* WT, int K, int k0, int n0, int dst_row0, float scale, LAS float* scr, int lane) {
#pragma unroll 8
    for (int i = 0; i < 32; ++i) { const int kk = 2 * i + (lane >> 5); scr[kk * 33 + (lane & 31)] = W[(size_t)(k0 + kk) * N + n0 + (lane & 31)] * scale; }
    LDS_WAIT(); asm volatile("" ::: "memory");
    const int c = lane & 7;
#pragma unroll
    for (int j = 0; j < 4; ++j) { const int n = (lane >> 3) + 8 * j; const LAS float* s = scr + (8 * c) * 33 + n;
        v4u o; o.x = pk2(s[0 * 33], s[1 * 33]); o.y = pk2(s[2 * 33], s[3 * 33]); o.z = pk2(s[4 * 33], s[5 * 33]); o.w = pk2(s[6 * 33], s[7 * 33]);
        *(v4u*)(WT + (size_t)(dst_row0 + n) * K + k0 + 8 * c) = o; }
    LDS_WAIT(); asm volatile("" ::: "memory");
}

__device__ __forceinline__ void p0_prologue(Frame& F) {
    {
        LAS float* sc = (LAS float*)F.lds;
        LAS float* red = (LAS float*)(F.lds + 16384);
        for (int i = F.tid; i < 4096; i += NTHREADS) { const float cv = F.c[i]; sc[i] = cv / (1.0f + __expf(-cv)); }
        __syncthreads();
        for (int item = F.bx; item < 96; item += F.G) {
            const int j = item * 64 + F.lane;
            float a0 = 0.f, a1 = 0.f, a2 = 0.f, a3 = 0.f;
            const int i0 = F.wave * 128;
#pragma unroll 4
            for (int i = i0; i < i0 + 128; ++i) {
                const float w = F.w_ada[(size_t)i * 6144 + j];
                a0 += sc[i] * w; a1 += sc[1024 + i] * w; a2 += sc[2048 + i] * w; a3 += sc[3072 + i] * w;
            }
            red[(F.wave * 4 + 0) * 64 + F.lane] = a0; red[(F.wave * 4 + 1) * 64 + F.lane] = a1;
            red[(F.wave * 4 + 2) * 64 + F.lane] = a2; red[(F.wave * 4 + 3) * 64 + F.lane] = a3;
            __syncthreads();
            if (F.wave < 4) {
                float s = F.b_ada[j];
#pragma unroll
                for (int w = 0; w < 8; ++w) s += red[(w * 4 + F.wave) * 64 + F.lane];
                F.ada[F.wave * 6144 + j] = s;
            }
            if (item < 32) {
                asm volatile("s_waitcnt vmcnt(0)" ::: "memory");
                __syncthreads();
                if (F.tid == 0) { __builtin_amdgcn_fence(__ATOMIC_RELEASE, "agent"); asm volatile("s_waitcnt vmcnt(0)" ::: "memory");
                                  __hip_atomic_fetch_add(F.ctl + CW_ADA, 1u, __ATOMIC_RELAXED, __HIP_MEMORY_SCOPE_AGENT); }
            }
            __syncthreads();
        }
        __syncthreads();
    }
    {
        LAS float* scr = (LAS float*)(F.lds + F.wave * 16384);
        constexpr int I_IN = 16 * 72, I_O = 16 * 32, I_Q = 16 * 64;
        for (int it = F.gw; it < I_IN + I_O + I_Q; it += F.ngw) {
            int r = it;
            if (r < I_IN) {
                const int kb = r / 72, nb = r % 72, n0 = 32 * nb;
                bf16* dst; int row0; float scale = 1.0f;
                if (n0 < 512) { dst = F.W1A; row0 = n0; scale = 0.125f * 1.4426950408889634f; }
                else if (n0 < 640) { dst = F.W1A; row0 = n0; }
                else if (n0 < 768) { dst = F.WVT; row0 = n0 - 640; }
                else if (n0 < 1280) { dst = F.W1A; row0 = n0 - 128; scale = 0.125f * 1.4426950408889634f; }
                else if (n0 < 1792) { dst = F.W1A; row0 = n0 - 128; }
                else { dst = F.WVT; row0 = 128 + (n0 - 1792); }
                p0_transpose_item(F.w_in, 2304, dst, D, 64 * kb, n0, row0, scale, scr, F.lane);
                continue;
            }
            r -= I_IN;
            if (r < I_O) { const int kb = r / 32, nb = r % 32; p0_transpose_item(F.w_out, 1024, F.WO, D, 64 * kb, 32 * nb, 32 * nb, 1.0f, scr, F.lane); continue; }
            r -= I_O;
            { const int kb = r / 64, nb = r % 64; p0_transpose_item(F.w_query, 2048, F.WQ, D, 64 * kb, 32 * nb, 32 * nb, 1.0f, scr, F.lane); }
        }
    }
    {
        const int gid = F.bx * NTHREADS + F.tid;
        if (gid < 16384) ((v4u*)(F.W1A + (size_t)1664 * D))[gid] = (v4u){0u, 0u, 0u, 0u};
        else if (gid < 32768) ((v4u*)(F.WVT + (size_t)640 * D))[gid - 16384] = (v4u){0u, 0u, 0u, 0u};
    }
    {
        for (int row0 = F.gw; row0 < 2 * NEXP; row0 += 4 * F.ngw) {
            f32x4 a[4][4];
#pragma unroll
            for (int u = 0; u < 4; ++u) { const int row = row0 + u * F.ngw; const bool isv = row >= NEXP; const int rr = isv ? row - NEXP : row;
                const f32x4* src = (const f32x4*)((isv ? F.vexp : F.uexp) + (size_t)rr * D) + 4 * F.lane;
                a[u][0] = src[0]; a[u][1] = src[1]; a[u][2] = src[2]; a[u][3] = src[3]; }
#pragma unroll
            for (int u = 0; u < 4; ++u) { const int row = row0 + u * F.ngw; const bool isv = row >= NEXP; const int rr = isv ? row - NEXP : row;
                float am = 0.f;
#pragma unroll
                for (int q = 0; q < 4; ++q) am = fmaxf(am, fmaxf(fmaxf(fabsf(a[u][q].x), fabsf(a[u][q].y)), fmaxf(fabsf(a[u][q].z), fabsf(a[u][q].w))));
                am = wave_max(am);
                const float inv = am > 0.f ? 127.0f / am : 0.f, scale = am * (1.0f / 127.0f);
                v4u o; o.x = q8x4(a[u][0], inv, 0); o.y = q8x4(a[u][1], inv, 0); o.z = q8x4(a[u][2], inv, 0); o.w = q8x4(a[u][3], inv, 0);
                *(v4u*)((isv ? F.V8 : F.U8) + ((size_t)(F.lane >> 3) * NEXP + rr) * 128 + (F.lane & 7) * 16) = o;
                if (F.lane == 0) (isv ? F.SV : F.SU)[rr] = scale; }
        }
        const size_t gid = (size_t)F.bx * NTHREADS + F.tid, gsz = (size_t)F.G * NTHREADS;
        for (size_t i = gid; i < 32768; i += gsz) {
            const int ln = (int)(i & 63), sk = (int)((i >> 6) & 7), nt = (int)((i >> 9) & 3), hh = (int)(i >> 11);
            const int n = 32 * nt + (ln & 31), d0 = 16 * sk + 8 * (ln >> 5);
            const f32x4* src = (const f32x4*)(F.sub_keys + ((size_t)hh * 128 + n) * 128 + d0);
            const f32x4 a = src[0], b = src[1];
            v4u o; o.x = pk2(a.x, a.y); o.y = pk2(a.z, a.w); o.z = pk2(b.x, b.y); o.w = pk2(b.z, b.w);
            ((v4u*)F.SK)[i] = o;
        }
    }
}

__device__ __forceinline__ void load_mod_vectors(f32x4 (&gs)[4], f32x4 (&sh)[4], const float* g, const float* shift, const float* scale, int lane) {
#pragma unroll
    for (int j = 0; j < 4; ++j) { const f32x4 gg = ((const f32x4*)g)[lane + 64 * j], sc = ((const f32x4*)scale)[lane + 64 * j]; gs[j] = gg * (sc + 1.0f); sh[j] = ((const f32x4*)shift)[lane + 64 * j]; }
}
__device__ __forceinline__ f32x4 load_row4(const float* row, int i4) { return ((const f32x4*)row)[i4]; }
__device__ __forceinline__ f32x4 load_row4(const bf16* row, int i4) { const v2u w = ((const v2u*)row)[i4]; return (f32x4){bflo(w.x), bfhi(w.x), bflo(w.y), bfhi(w.y)}; }
template <bool Q8, class TIN>
__device__ __forceinline__ void norm_mod_row(const TIN* xrow, bf16* orow, const f32x4 (&gs)[4], const f32x4 (&sh)[4], int lane, unsigned char* qrow = nullptr, float* qscale = nullptr) {
    f32x4 v[4]; float ss = 0.f;
#pragma unroll
    for (int j = 0; j < 4; ++j) { v[j] = load_row4(xrow, lane + 64 * j); ss += (v[j].x * v[j].x + v[j].y * v[j].y) + (v[j].z * v[j].z + v[j].w * v[j].w); }
    ss = wave_sum(ss);
    const float rstd = 1.0f / sqrtf(ss * (1.0f / 1024.0f) + EPS);
    unsigned long long* o8 = (unsigned long long*)orow + lane;
    float am = 0.f;
#pragma unroll
    for (int j = 0; j < 4; ++j) {
        const f32x4 y = v[j] * rstd * gs[j] + sh[j];
        o8[64 * j] = (unsigned long long)pk2(y.x, y.y) | ((unsigned long long)pk2(y.z, y.w) << 32);
        if (Q8) { v[j] = y; am = fmaxf(am, fmaxf(fmaxf(fabsf(y.x), fabsf(y.y)), fmaxf(fabsf(y.z), fabsf(y.w)))); }
    }
    if (Q8) {
        am = wave_max(am);
        const float inv = am > 0.f ? 127.0f / am : 0.f;
#pragma unroll
        for (int j = 0; j < 4; ++j) ((unsigned*)qrow)[lane + 64 * j] = q8x4(v[j], inv, 0);
        if (lane == 0) *qscale = am * (1.0f / 127.0f);
    }
}

__device__ __forceinline__ int t5_bucket_rel(int rel) {
    const int n = rel < 0 ? -rel : rel; int v;
    if (n < 8) v = n; else if (n < 12) v = 8; else if (n < 16) v = 9; else if (n < 23) v = 10; else if (n < 32) v = 11;
    else if (n < 46) v = 12; else if (n < 64) v = 13; else if (n < 91) v = 14; else v = 15;
    return (rel > 0 ? 16 : 0) + v;
}
__device__ __forceinline__ bf16x8 pack8(const float* p) {
    v4u w; w.x = pk2(p[0], p[1]); w.y = pk2(p[2], p[3]); w.z = pk2(p[4], p[5]); w.w = pk2(p[6], p[7]);
    return __builtin_bit_cast(bf16x8, w);
}
struct KFrag { bf16x8 k[4]; };
struct VFrag { v4u v[2][2]; };
__device__ __forceinline__ void load_k(KFrag& f, const bf16* blk) {
#pragma unroll
    for (int s = 0; s < 4; ++s) f.k[s] = *(const bf16x8*)(blk + 512 * s);
}
__device__ __forceinline__ void load_v(VFrag& f, const bf16* blk) {
#pragma unroll
    for (int dt = 0; dt < 2; ++dt)
#pragma unroll
        for (int s = 0; s < 2; ++s) f.v[dt][s] = *(const v4u*)(blk + (dt * 2 + s) * 512);
}
__device__ __forceinline__ f32x16 score_tile(const KFrag& kf, const bf16x8 (&qf)[4], f32x16 st) {
#pragma unroll
    for (int s = 0; s < 4; ++s) st = MFMA32(kf.k[s], qf[s], st);
    return st;
}
template <int RANGE>
__device__ __forceinline__ void attn_tile_update(const float (&sv)[16], float& m_run, float& l_run, f32x16 (&o)[2], const VFrag& f) {
    constexpr int LO = RANGE == 2 ? 12 : 0, HI = RANGE == 1 ? 4 : 16;
    float mx = sv[LO];
#pragma unroll
    for (int i = LO + 1; i < HI; ++i) mx = fmaxf(mx, sv[i]);
    mx = xhalf_max(mx);
    const float m_new = fmaxf(m_run, mx);
    const float alpha = __builtin_amdgcn_exp2f(m_run - m_new);
    float p[16]; float ls = 0.f;
#pragma unroll
    for (int i = 0; i < 16; ++i) { if (i >= LO && i < HI) { p[i] = __builtin_amdgcn_exp2f(sv[i] - m_new); ls += p[i]; } else p[i] = 0.f; }
    l_run = l_run * alpha + ls; m_run = m_new;
    if (__builtin_amdgcn_ballot_w64(alpha != 1.0f) != 0ull) {
#pragma unroll
        for (int dt = 0; dt < 2; ++dt)
#pragma unroll
            for (int i = 0; i < 16; ++i) o[dt][i] *= alpha;
    }
    if (RANGE != 2) { const bf16x8 pf0 = pack8(p);
#pragma unroll
        for (int dt = 0; dt < 2; ++dt) o[dt] = MFMA32(__builtin_bit_cast(bf16x8, f.v[dt][0]), pf0, o[dt]); }
    if (RANGE != 1) { const bf16x8 pf1 = pack8(p + 8);
#pragma unroll
        for (int dt = 0; dt < 2; ++dt) o[dt] = MFMA32(__builtin_bit_cast(bf16x8, f.v[dt][1]), pf1, o[dt]); }
}
__device__ __forceinline__ void attn_finalize(Frame& F, f32x16 (&o)[2], float l_run, LAS float* ssq, const float* gain  , bf16* orow  , int head, int r, int h) {
    const float lt = xhalf_sum(l_run);
    const float inv = 1.0f / lt;
    float sq = 0.f;
#pragma unroll
    for (int dt = 0; dt < 2; ++dt)
#pragma unroll
        for (int i = 0; i < 16; ++i) { o[dt][i] *= inv; sq += o[dt][i] * o[dt][i]; }
    sq = xhalf_sum(sq);
    if (h == 0) ssq[head * 32 + r] = sq;
    __syncthreads();
    float tot = 0.f;
#pragma unroll
    for (int hd = 0; hd < 8; ++hd) tot += ssq[hd * 32 + r];
    const float rstd = 1.0f / sqrtf(tot * (1.0f / 512.0f) + EPS);
    __syncthreads();
#pragma unroll
    for (int dt = 0; dt < 2; ++dt)
#pragma unroll
        for (int g = 0; g < 4; ++g) {
            const int d = head * 64 + 32 * dt + 8 * g + 4 * h;
            const f32x4 gv = *(const f32x4*)(gain + d);
            v2u w; w.x = pk2(o[dt][4 * g] * rstd * gv.x, o[dt][4 * g + 1] * rstd * gv.y); w.y = pk2(o[dt][4 * g + 2] * rstd * gv.z, o[dt][4 * g + 3] * rstd * gv.w);
            *(v2u*)(orow + d) = w;
        }
}

__device__ __forceinline__ void attn_finalize2(f32x16 (&o)[2][2], const float (&l_run)[2], LAS float* ssq, const float* gain, bf16* orow, int head0, int r, int h) {
#pragma unroll
    for (int e = 0; e < 2; ++e) {
        const float lt = xhalf_sum(l_run[e]);
        const float inv = 1.0f / lt;
        float sq = 0.f;
#pragma unroll
        for (int dt = 0; dt < 2; ++dt)
#pragma unroll
            for (int i = 0; i < 16; ++i) { o[e][dt][i] *= inv; sq += o[e][dt][i] * o[e][dt][i]; }
        sq = xhalf_sum(sq);
        if (h == 0) ssq[(head0 + e) * 32 + r] = sq;
    }
    __syncthreads();
    float tot = 0.f;
#pragma unroll
    for (int hd = 0; hd < 8; ++hd) tot += ssq[hd * 32 + r];
    const float rstd = 1.0f / sqrtf(tot * (1.0f / 512.0f) + EPS);
    __syncthreads();
#pragma unroll
    for (int e = 0; e < 2; ++e)
#pragma unroll
        for (int dt = 0; dt < 2; ++dt)
#pragma unroll
            for (int g = 0; g < 4; ++g) {
                const int d = (head0 + e) * 64 + 32 * dt + 8 * g + 4 * h;
                const f32x4 gv = *(const f32x4*)(gain + d);
                v2u w; w.x = pk2(o[e][dt][4 * g] * rstd * gv.x, o[e][dt][4 * g + 1] * rstd * gv.y); w.y = pk2(o[e][dt][4 * g + 2] * rstd * gv.z, o[e][dt][4 * g + 3] * rstd * gv.w);
                *(v2u*)(orow + d) = w;
            }
}
__device__ __forceinline__ void attn_phase(Frame& F) {
    constexpr float LOG2E = 1.4426950408889634f;
    LAS float* tb = (LAS float*)F.lds;
    LAS float* rp = (LAS float*)(F.lds + 11264);
    LAS float* ssq = (LAS float*)(F.lds + 11264 + 61440);
    for (int i = F.tid; i < 8 * 352; i += NTHREADS) { const int hd = i / 352, rel = i % 352 - 160; tb[i] = (rel >= -128 && rel <= 128) ? F.t5[t5_bucket_rel(rel) * 8 + hd] * LOG2E : -1e30f; }
    for (int i = F.tid; i < 8 * 15 * 128; i += NTHREADS) { const int co = (i & 127) - 48, hr = i >> 7; rp[i] = (co >= 0 && co <= 30) ? F.rpb[hr * 31 + co] * LOG2E : 0.f; }
    __syncthreads();
    const int head = F.wave, kvh = head >> 2, r = F.lane & 31, h = F.lane >> 5;
    const int vcu = (F.G % 8 == 0) ? (F.bx % 8) * (F.G / 8) + F.bx / 8 : F.bx;
    for (int unit = vcu; unit < 1024; unit += F.G) {
        const int b = unit >> 8, q0 = (unit & 255) * 32;
        const int qtile = (b * S + q0) >> 5;
        const bf16* qblk = F.PROJ + (size_t)head * M * 64 + (size_t)qtile * 2048 + F.lane * 8;
        bf16x8 qf[4];
#pragma unroll
        for (int s = 0; s < 4; ++s) qf[s] = *(const bf16x8*)(qblk + 512 * s);
        float m_run = F.sink[head] * LOG2E, l_run = (h == 0) ? 1.0f : 0.0f;
        f32x16 o[2];
#pragma unroll
        for (int dt = 0; dt < 2; ++dt)
#pragma unroll
            for (int i = 0; i < 16; ++i) o[dt][i] = 0.f;
        const int kt_lo = (q0 >= 128) ? -4 : -(q0 >> 5), kt_hi = (q0 + 32 + 128 <= S) ? 4 : ((S - 32 - q0) >> 5);
        const bf16* kbase = F.PROJ + (size_t)(8 + kvh) * M * 64 + (size_t)qtile * 2048 + F.lane * 8;
        const bf16* vbase = F.VT + (size_t)kvh * M * 64 + (size_t)qtile * 2048 + F.lane * 8;
        f32x16 st;
        const LAS float* tbl0 = tb + head * 352 + 160 - r + 4 * h;
        { KFrag k0; load_k(k0, kbase + (ptrdiff_t)kt_lo * 2048); f32x16 ini;
#pragma unroll
          for (int i = 0; i < 16; ++i) ini[i] = tbl0[32 * kt_lo + (i & 3) + 8 * (i >> 2)];
          st = score_tile(k0, qf, ini); }
        for (int kt = kt_lo; kt <= kt_hi; ++kt) {
            const int ktn = kt < kt_hi ? kt + 1 : kt;
            KFrag kn; VFrag vc;
            load_k(kn, kbase + (ptrdiff_t)ktn * 2048);
            load_v(vc, vbase + (ptrdiff_t)kt * 2048);
            f32x16 ini;
#pragma unroll
            for (int i = 0; i < 16; ++i) ini[i] = tbl0[32 * ktn + (i & 3) + 8 * (i >> 2)];
            float sv[16];
#pragma unroll
            for (int i = 0; i < 16; ++i) sv[i] = st[i];
            attn_tile_update<0>(sv, m_run, l_run, o, vc);
            st = score_tile(kn, qf, ini);
        }
        attn_finalize(F, o, l_run, ssq, F.gna, F.MIX + (size_t)(b * S + q0 + r) * D, head, r, h);
    }
    for (int unit = vcu; unit < 512; unit += F.G) {
        const int b = unit >> 7, rg = unit & 127;
        const int rs = (rg - 4) < 0 ? 0 : ((rg - 4) > 120 ? 120 : (rg - 4));
        bf16x8 qf[2][4]; unsigned vm[2]; int cq[2];
#pragma unroll
        for (int qh = 0; qh < 2; ++qh) {
            const int c = 32 * qh + r; cq[qh] = c;
            const int cs = (c - 8) < 0 ? 0 : ((c - 8) > 48 ? 48 : (c - 8));
            const bf16* qblk = F.PROJ + (size_t)(10 + head) * M * 64 + (size_t)(b * 256 + rg * 2 + qh) * 2048 + F.lane * 8;
#pragma unroll
            for (int s = 0; s < 4; ++s) qf[qh][s] = *(const bf16x8*)(qblk + 512 * s);
            unsigned m = 0u;
#pragma unroll
            for (int ct = 0; ct < 2; ++ct)
#pragma unroll
                for (int i = 0; i < 16; ++i) { const int kc = ct * 32 + (i & 3) + 8 * (i >> 2) + 4 * h; m |= (kc >= cs && kc < cs + 16) ? (1u << (16 * ct + i)) : 0u; }
            vm[qh] = m;
        }
        float m_run[2] = {-1e30f, -1e30f}, l_run[2] = {0.0f, 0.0f};
        f32x16 o[2][2];
#pragma unroll
        for (int qh = 0; qh < 2; ++qh)
#pragma unroll
            for (int dt = 0; dt < 2; ++dt)
#pragma unroll
                for (int i = 0; i < 16; ++i) o[qh][dt][i] = 0.f;
        const bf16* kbase = F.PROJ + (size_t)(18 + head) * M * 64 + (size_t)(b * 256 + rs * 2) * 2048 + F.lane * 8;
        const bf16* vbase = F.VT + (size_t)(2 + head) * M * 64 + (size_t)(b * 256 + rs * 2) * 2048 + F.lane * 8;
        f32x16 st[2];
#define NB_INIT(dst, qh, kr_, ct_) do { const LAS float* _rp = rp + (head * 15 + ((kr_) - rg + 7)) * 128 + 48 + (ct_) * 32 + 4 * h - cq[qh] + 15; const unsigned _vm = vm[qh] >> (16 * (ct_)); \
            _Pragma("unroll") for (int i = 0; i < 16; ++i) dst[i] = ((_vm >> i) & 1u) ? _rp[(i & 3) + 8 * (i >> 2)] : -1e30f; } while (0)
        { KFrag k0; load_k(k0, kbase); f32x16 i0, i1; NB_INIT(i0, 0, rs, 0); NB_INIT(i1, 1, rs, 0); st[0] = score_tile(k0, qf[0], i0); st[1] = score_tile(k0, qf[1], i1); }
#pragma unroll 1
        for (int kp = 0; kp < 8; ++kp) {
            const int kr = rs + kp;
#pragma unroll
            for (int ct = 0; ct < 2; ++ct) {
                const int kti = 2 * kp + ct;
                const int ktn = kti < 15 ? kti + 1 : kti;
                KFrag kn; VFrag vc;
                load_k(kn, kbase + (size_t)ktn * 2048);
                load_v(vc, vbase + (size_t)kti * 2048);
                f32x16 i0, i1;
                if (ct == 0) { NB_INIT(i0, 0, kr, 1); NB_INIT(i1, 1, kr, 1); } else { NB_INIT(i0, 0, kr + 1, 0); NB_INIT(i1, 1, kr + 1, 0); }
#pragma unroll
                for (int qh = 0; qh < 2; ++qh) {
                    float sv[16];
#pragma unroll
                    for (int i = 0; i < 16; ++i) sv[i] = st[qh][i];
                    if (qh == 0 && ct == 1) attn_tile_update<1>(sv, m_run[qh], l_run[qh], o[qh], vc);
                    else if (qh == 1 && ct == 0) attn_tile_update<2>(sv, m_run[qh], l_run[qh], o[qh], vc);
                    else attn_tile_update<0>(sv, m_run[qh], l_run[qh], o[qh], vc);
                }
                st[0] = score_tile(kn, qf[0], i0); st[1] = score_tile(kn, qf[1], i1);
            }
        }
#undef NB_INIT
#pragma unroll
        for (int qh = 0; qh < 2; ++qh)
            attn_finalize(F, o[qh], l_run[qh], ssq, F.gnb, F.MIX + (size_t)(b * S + rg * 64 + cq[qh]) * D + 512, head, r, h);
    }
}

__device__ __forceinline__ float tag_f(float v, unsigned tag, unsigned mask) { return __builtin_bit_cast(float, (__builtin_bit_cast(unsigned, v) & ~mask) | tag); }
#define CEX(a, b) do { const float _hi = fmaxf(a, b), _lo = fminf(a, b); a = _hi; b = _lo; } while (0)
template <int N> __device__ __forceinline__ void bitonic_sort_desc(float (&v)[N]) {
#pragma unroll
    for (int k = 2; k <= N; k <<= 1)
#pragma unroll
        for (int j = k >> 1; j > 0; j >>= 1)
#pragma unroll
            for (int i = 0; i < N; ++i) {
                const int l = i ^ j;
                if (l > i) { if ((i & k) == 0) { CEX(v[i], v[l]); } else { CEX(v[l], v[i]); } }
            }
}
__device__ __forceinline__ void bitonic_merge16_desc(float (&v)[16]) {
#pragma unroll
    for (int j = 8; j > 0; j >>= 1)
#pragma unroll
        for (int i = 0; i < 16; ++i) { const int l = i ^ j; if (l > i) CEX(v[i], v[l]); }
}
__device__ __forceinline__ void top16_merge(float (&a)[16], const float (&b)[16]) {
#pragma unroll
    for (int i = 0; i < 16; ++i) a[i] = fmaxf(a[i], b[15 - i]);
    bitonic_merge16_desc(a);
}
__device__ __forceinline__ void top16_pair(const f32x16 (&st)[4], int h, float (&out)[16]) {
    float g[4][16];
#pragma unroll
    for (int nt = 0; nt < 4; ++nt) {
#pragma unroll
        for (int i = 0; i < 16; ++i) g[nt][i] = tag_f(st[nt][i], (unsigned)(32 * nt + crow(i, h)), 127u);
        bitonic_sort_desc<16>(g[nt]);
    }
    top16_merge(g[0], g[1]); top16_merge(g[2], g[3]); top16_merge(g[0], g[2]);
    float th[16];
#pragma unroll
    for (int i = 0; i < 16; ++i) halves(g[0][i], out[i], th[i]);
    top16_merge(out, th);
}

__device__ __forceinline__ void route_phase(Frame& F) {
    const int r = F.lane & 31, h = F.lane >> 5;
    const int head = F.bx & 7;
    for (int i = F.tid; i < 4096; i += NTHREADS) ((LAS v4u*)F.lds)[i] = ((const v4u*)(F.SK + (size_t)head * 2 * 128 * 128))[i];
    __syncthreads();
    LAS int* scr = (LAS int*)(F.lds + 65536 + F.wave * 8192) + F.lane;
    for (int tg = F.bx >> 3; tg < 128; tg += F.G >> 3) {
        const int t0 = (tg * 8 + F.wave) * 32;
        float lst[2][16];
#pragma unroll
        for (int half = 0; half < 2; ++half) {
            const bf16* qblk = F.QP + (size_t)(head * 4 + half * 2) * M * 64 + (size_t)(t0 >> 5) * 2048 + F.lane * 8;
            bf16x8 qf[8];
#pragma unroll
            for (int s = 0; s < 8; ++s) qf[s] = *(const bf16x8*)(qblk + (size_t)(s >> 2) * M * 64 + (s & 3) * 512);
            const LAS unsigned char* sk = F.lds + half * 32768 + F.lane * 16;
            f32x16 st[4];
#pragma unroll
            for (int nt = 0; nt < 4; ++nt) {
#pragma unroll
                for (int i = 0; i < 16; ++i) st[nt][i] = 0.f;
#pragma unroll
                for (int s = 0; s < 8; ++s) st[nt] = MFMA32(*(const LAS bf16x8*)(sk + (nt * 8 + s) * 1024), qf[s], st[nt]);
                __builtin_amdgcn_sched_barrier(0);
            }
            top16_pair(st, h, lst[half]);
            __builtin_amdgcn_sched_barrier(0);
        }
#pragma unroll
        for (int i = 0; i < 16; ++i) { scr[i * 64] = (int)(__builtin_bit_cast(unsigned, lst[0][i]) & 127u); scr[(16 + i) * 64] = (int)(__builtin_bit_cast(unsigned, lst[1][i]) & 127u); }
        constexpr float NEGINF = -3.0e38f;
        float win[16], tmp[16];
#pragma unroll
        for (int j = 0; j < 16; ++j) win[j] = tag_f(lst[0][0] + lst[1][j], (unsigned)j, 255u);
#pragma unroll
        for (int i = 1; i < 8; ++i) {
#pragma unroll
            for (int j = 0; j < 16; ++j) tmp[j] = ((i + 1) * (j + 1) <= 16) ? tag_f(lst[0][i] + lst[1][j], (unsigned)(i * 16 + j), 255u) : NEGINF;
            top16_merge(win, tmp);
        }
#pragma unroll
        for (int j = 0; j < 16; ++j) tmp[j] = (j < 8) ? tag_f(lst[0][8 + j] + lst[1][0], (unsigned)((8 + j) * 16), 255u) : NEGINF;
        top16_merge(win, tmp);
        float e[16]; float es = 0.f;
#pragma unroll
        for (int k = 0; k < 16; ++k) { e[k] = __expf(win[k] - win[0]); es += e[k]; }
        const float einv = 1.0f / es;
        LDS_WAIT(); asm volatile("" ::: "memory");
        int ex[16];
#pragma unroll
        for (int k = 0; k < 16; ++k) { const unsigned code = __builtin_bit_cast(unsigned, win[k]) & 255u; ex[k] = scr[(code >> 4) * 64] * 128 + scr[(16 + (code & 15u)) * 64]; }
        if (h == 0) {
            int* ip = F.IDX + (size_t)(t0 + r) * 128 + head * 16; float* gp = F.GT + (size_t)(t0 + r) * 128 + head * 16;
#pragma unroll
            for (int k4 = 0; k4 < 4; ++k4) {
                *(v4u*)(ip + 4 * k4) = (v4u){(unsigned)ex[4 * k4], (unsigned)ex[4 * k4 + 1], (unsigned)ex[4 * k4 + 2], (unsigned)ex[4 * k4 + 3]};
                *(f32x4*)(gp + 4 * k4) = (f32x4){e[4 * k4] * einv, e[4 * k4 + 1] * einv, e[4 * k4 + 2] * einv, e[4 * k4 + 3] * einv};
            }
        }
        LDS_WAIT(); asm volatile("" ::: "memory");
    }
}

__device__ __forceinline__ float gelu_tanh(float z) {
    const float u = 0.7978845608028654f * (z + 0.044715f * z * z * z);
    const float t = 1.0f - 2.0f / (__expf(2.0f * u) + 1.0f);
    return 0.5f * z * (1.0f + t);
}
__device__ __forceinline__ int rev4(int k) { return ((k & 1) << 3) | ((k & 2) << 1) | ((k & 4) >> 1) | ((k & 8) >> 3); }
__device__ __forceinline__ int idot16(const v4u& a, const v4u& b) {
    int r = __builtin_amdgcn_sdot4((int)a.x, (int)b.x, 0, false); r = __builtin_amdgcn_sdot4((int)a.y, (int)b.y, r, false);
    r = __builtin_amdgcn_sdot4((int)a.z, (int)b.z, r, false); return __builtin_amdgcn_sdot4((int)a.w, (int)b.w, r, false);
}
__device__ __forceinline__ void fma4u(float (&acc)[16], int o, unsigned w, float a) {
    acc[o + 0] += a * (float)(w & 0xffu); acc[o + 1] += a * (float)((w >> 8) & 0xffu); acc[o + 2] += a * (float)((w >> 16) & 0xffu); acc[o + 3] += a * (float)(w >> 24);
}
constexpr int MB_IDX_PITCH = 528, MB_AUX_OFF = 8 * 528, MB_AUX_PITCH = 144, MB_BYTES = 6144;
struct VMeta { v4u n[4]; v4u a; };
__device__ __forceinline__ void v_gather(v4u (&vq)[16], const VMeta& m, const unsigned char* vbase, unsigned c16) {
#pragma unroll
    for (int i = 0; i < 16; ++i) vq[i] = *(const v4u*)(vbase + (unsigned)(m.n[i >> 2][i & 3] * 128u + c16));
}
__device__ __forceinline__ void v_accumulate(int (&acc)[16], const v4u (&vq)[16], const v4u al) {
#pragma unroll
    for (int a = 0; a < 4; ++a)
#pragma unroll
        for (int b = 0; b < 4; ++b) {
            const unsigned r0 = vq[4 * a + 0][b], r1 = vq[4 * a + 1][b], r2 = vq[4 * a + 2][b], r3 = vq[4 * a + 3][b];
            const unsigned t0 = __builtin_amdgcn_perm(r1, r0, 0x05010400u), t1 = __builtin_amdgcn_perm(r1, r0, 0x07030602u);
            const unsigned t2 = __builtin_amdgcn_perm(r3, r2, 0x05010400u), t3 = __builtin_amdgcn_perm(r3, r2, 0x07030602u);
            const unsigned c0 = __builtin_amdgcn_perm(t2, t0, 0x05040100u), c1 = __builtin_amdgcn_perm(t2, t0, 0x07060302u);
            const unsigned c2 = __builtin_amdgcn_perm(t3, t1, 0x05040100u), c3 = __builtin_amdgcn_perm(t3, t1, 0x07060302u);
            acc[4 * b + 0] = __builtin_amdgcn_sdot4((int)c0, (int)al[a], acc[4 * b + 0], false);
            acc[4 * b + 1] = __builtin_amdgcn_sdot4((int)c1, (int)al[a], acc[4 * b + 1], false);
            acc[4 * b + 2] = __builtin_amdgcn_sdot4((int)c2, (int)al[a], acc[4 * b + 2], false);
            acc[4 * b + 3] = __builtin_amdgcn_sdot4((int)c3, (int)al[a], acc[4 * b + 3], false);
        }
}

__device__ __forceinline__ void peer_fused_phase(Frame& F, bf16* pout) {
    const int lane = F.lane, g = lane >> 3, c = lane & 7;
    const bool b0 = c & 1, b1 = c & 2, b2 = c & 4;
    const int i0c = 8 * (c & 1) + 4 * ((c >> 1) & 1) + 2 * ((c >> 2) & 1);
    LAS unsigned char* wl = F.lds + F.wave * 16384;
    constexpr int L_IDX = 0, L_AUXZ = 16 * MB_IDX_PITCH, L_AUXV = L_AUXZ + 2 * 8 * MB_AUX_PITCH;
    const int xcc = (int)(xb_xcc_id() & 7u);
    for (int grp = F.gw; grp < M / 16; grp += F.ngw) {
    const int it0 = grp * 2;
    const int tkl = lane >> 3, q = lane & 7;
#pragma unroll
    for (int item = 0; item < 2; ++item) {
        const v4u* ip = (const v4u*)(F.IDX + (size_t)((it0 + item) * 8 + tkl) * 128 + 16 * q);
        const v4u a0 = ip[0], a1 = ip[1], a2 = ip[2], a3 = ip[3];
        LAS v4u* p = (LAS v4u*)(wl + L_IDX + (item * 8 + tkl) * MB_IDX_PITCH + q * 64);
        p[0] = a0; p[1] = a1; p[2] = a2; p[3] = a3;
    }
    int zacc[16][2];
#pragma unroll
    for (int i = 0; i < 16; ++i) { zacc[i][0] = 0; zacc[i][1] = 0; }
    {
        int buf = 0;
        { const v4u x0 = *(const v4u*)(F.X8 + (size_t)(it0 * 8 + tkl) * D + xcc * 128 + 16 * q); *(LAS v4u*)(wl + L_AUXZ + tkl * MB_AUX_PITCH + q * 16) = x0; }
#pragma unroll 1
        for (int k = 0; k < 8; ++k) {
            const int s = (xcc + k) & 7, sn = (xcc + k + 1) & 7;
            const unsigned char* ubase = F.U8 + (size_t)s * NEXP * 128;
#pragma unroll
            for (int item = 0; item < 2; ++item) {
                const v4u xn = *(const v4u*)(F.X8 + (size_t)((item == 0 ? it0 + 1 : it0) * 8 + tkl) * D + (item == 0 ? s : sn) * 128 + 16 * q);
                const LAS unsigned char* ib = wl + L_IDX + item * 8 * MB_IDX_PITCH;
                const LAS unsigned char* xb = wl + L_AUXZ + buf * 8 * MB_AUX_PITCH;
#pragma unroll
                for (int tt = 0; tt < 8; ++tt) {
                    const LAS v4u* ip = (const LAS v4u*)(ib + tt * MB_IDX_PITCH + g * 64);
                    const v4u n0 = ip[0], n1 = ip[1], n2 = ip[2], n3 = ip[3];
                    const v4u xq = *(const LAS v4u*)(xb + tt * MB_AUX_PITCH + c * 16);
                    const unsigned e[16] = {n0.x, n0.y, n0.z, n0.w, n1.x, n1.y, n1.z, n1.w, n2.x, n2.y, n2.z, n2.w, n3.x, n3.y, n3.z, n3.w};
                    v4u uq[16];
#pragma unroll
                    for (int i = 0; i < 16; ++i) uq[i] = *(const v4u*)(ubase + (unsigned)(e[i] * 128u + (unsigned)c * 16u));
                    int p[16];
#pragma unroll
                    for (int i = 0; i < 16; ++i) p[i] = idot16(uq[i], xq);
                    int q8_[8], q4_[4], q2_[2];
#pragma unroll
                    for (int i = 0; i < 8; ++i) { const int keep = b0 ? p[8 + i] : p[i], send = b0 ? p[i] : p[8 + i]; q8_[i] = keep + dppi<DPP_XOR1>(send); }
#pragma unroll
                    for (int i = 0; i < 4; ++i) { const int keep = b1 ? q8_[4 + i] : q8_[i], send = b1 ? q8_[i] : q8_[4 + i]; q4_[i] = keep + dppi<DPP_XOR2>(send); }
#pragma unroll
                    for (int i = 0; i < 2; ++i) { const int keep = b2 ? q4_[2 + i] : q4_[i], send = b2 ? q4_[i] : q4_[2 + i]; q2_[i] = keep + __shfl_xor(send, 4); }
                    zacc[item * 8 + tt][0] += q2_[0]; zacc[item * 8 + tt][1] += q2_[1];
                }
                buf ^= 1;
                *(LAS v4u*)(wl + L_AUXZ + buf * 8 * MB_AUX_PITCH + tkl * MB_AUX_PITCH + q * 16) = xn;
                __builtin_amdgcn_sched_barrier(0);
            }
        }
    }
#pragma unroll
    for (int tk = 0; tk < 16; ++tk) {
        const int t = it0 * 8 + tk, j0 = 16 * g + i0c;
        const v2u e = *(const LAS v2u*)(wl + L_IDX + tk * MB_IDX_PITCH + j0 * 4);
        const float* gp = F.GT + (size_t)t * 128 + j0;
        const float sx = F.SX[t];
        const float a0 = gelu_tanh((float)zacc[tk][0] * (sx * F.SU[e.x])) * gp[0] * F.SV[e.x];
        const float a1 = gelu_tanh((float)zacc[tk][1] * (sx * F.SU[e.y])) * gp[1] * F.SV[e.y];
        const float am = wave_max(fmaxf(fabsf(a0), fabsf(a1)));
        const float inv = am > 0.f ? 127.0f / am : 0.f;
        *(LAS unsigned short*)(wl + L_AUXV + tk * MB_AUX_PITCH + j0) = (unsigned short)(q8(a0, inv, 0) | (q8(a1, inv, 0) << 8));
        zacc[tk][0] = __builtin_bit_cast(int, am * (1.0f / 127.0f));
    }
    {
        const int tk = lane >> 3;
        float sa2[2];
#pragma unroll
        for (int item = 0; item < 2; ++item) { float v = 0.f;
#pragma unroll
            for (int j = 0; j < 8; ++j) v = (tk == j) ? __builtin_bit_cast(float, zacc[item * 8 + j][0]) : v;
            sa2[item] = v; }
#pragma unroll 1
        for (int k = 0; k < 8; ++k) {
            const int s = (xcc + k) & 7;
            const unsigned char* vbase = F.V8 + (size_t)s * NEXP * 128;
#pragma unroll
            for (int item = 0; item < 2; ++item) {
                const LAS unsigned char* ib = wl + L_IDX + (item * 8 + tk) * MB_IDX_PITCH;
                const LAS unsigned char* ab = wl + L_AUXV + (item * 8 + tk) * MB_AUX_PITCH;
                const int t = (it0 + item) * 8 + tk;
                int acc[16];
#pragma unroll
                for (int i = 0; i < 16; ++i) acc[i] = 0;
                VMeta mt[2]; v4u vq[2][16];
#pragma unroll
                for (int u = 0; u < 2; ++u) { const LAS v4u* ip = (const LAS v4u*)(ib + u * 64); mt[u].n[0] = ip[0]; mt[u].n[1] = ip[1]; mt[u].n[2] = ip[2]; mt[u].n[3] = ip[3]; mt[u].a = *(const LAS v4u*)(ab + u * 16); }
                v_gather(vq[0], mt[0], vbase, (unsigned)c * 16u);
#pragma unroll
                for (int i = 0; i < 8; ++i) {
                    const int cur = i & 1, nxt = cur ^ 1;
                    const v4u al = mt[cur].a;
                    if (i + 1 < 8) v_gather(vq[nxt], mt[nxt], vbase, (unsigned)c * 16u);
                    if (i + 2 < 8) { const LAS v4u* ip = (const LAS v4u*)(ib + (i + 2) * 64); mt[cur].n[0] = ip[0]; mt[cur].n[1] = ip[1]; mt[cur].n[2] = ip[2]; mt[cur].n[3] = ip[3]; mt[cur].a = *(const LAS v4u*)(ab + (i + 2) * 16); }
                    v_accumulate(acc, vq[cur], al);
                }
                const float sa = sa2[item];
                v4u w0, w1;
                w0.x = pk2(sa * (float)acc[0], sa * (float)acc[1]);   w0.y = pk2(sa * (float)acc[2], sa * (float)acc[3]);
                w0.z = pk2(sa * (float)acc[4], sa * (float)acc[5]);   w0.w = pk2(sa * (float)acc[6], sa * (float)acc[7]);
                w1.x = pk2(sa * (float)acc[8], sa * (float)acc[9]);   w1.y = pk2(sa * (float)acc[10], sa * (float)acc[11]);
                w1.z = pk2(sa * (float)acc[12], sa * (float)acc[13]); w1.w = pk2(sa * (float)acc[14], sa * (float)acc[15]);
                v4u* po = (v4u*)(pout + (size_t)t * D + s * 128 + 16 * c);
                po[0] = w0; po[1] = w1;
                __builtin_amdgcn_sched_barrier(0);
            }
        }
    }
    asm volatile("s_waitcnt vmcnt(0)" ::: "memory");
    {
        int ln = lane; asm volatile("" : "+v"(ln));
        const int tb = it0 * 8;
        const float* gate2 = F.ada + (size_t)(tb >> 13) * 6144 + 5120;
        f32x4 gt[4], gf[4];
#pragma unroll
        for (int j = 0; j < 4; ++j) { gt[j] = ((const f32x4*)gate2)[ln + 64 * j]; gf[j] = ((const f32x4*)F.gfin)[ln + 64 * j]; }
        for (int k = 0; k < 16; k += 2)
#pragma unroll
        for (int u2 = 0; u2 < 2; ++u2) { const int t = tb + k + u2;
            f32x4* xr = (f32x4*)(F.out + (size_t)t * D) + ln;
            const bf16* x1row = F.X1 + (size_t)t * D;
            const v2u* pr = (const v2u*)(pout + (size_t)t * D) + ln;
            f32x4 v[4]; float ss = 0.f;
#pragma unroll
            for (int j = 0; j < 4; ++j) {
                const f32x4 x1 = load_row4(x1row, ln + 64 * j); const v2u pw = pr[64 * j];
                f32x4 y; y.x = x1.x + gt[j].x * bflo(pw.x); y.y = x1.y + gt[j].y * bfhi(pw.x); y.z = x1.z + gt[j].z * bflo(pw.y); y.w = x1.w + gt[j].w * bfhi(pw.y);
                v[j] = y; ss += (y.x * y.x + y.y * y.y) + (y.z * y.z + y.w * y.w);
            }
            ss = wave_sum(ss);
            const float rstd = 1.0f / sqrtf(ss * (1.0f / 1024.0f) + EPS);
#pragma unroll
            for (int j = 0; j < 4; ++j) xr[64 * j] = v[j] * rstd * gf[j];
        }
    }
    }
}

__global__ void __launch_bounds__(NTHREADS, 2) hymba_fwd(Args args) {
    extern __shared__ __attribute__((aligned(16))) unsigned char lds[];
    Frame F;
    F.lds = (LAS unsigned char*)lds;
    F.tid = threadIdx.x; F.lane = F.tid & 63; F.wave = __builtin_amdgcn_readfirstlane(F.tid >> 6);
    F.G = gridDim.x; F.bx = blockIdx.x; F.gw = F.bx * NWAVES + F.wave; F.ngw = F.G * NWAVES;
    unsigned char* ws = args.ws;
    F.x = args.in[0]; F.c = args.in[1]; F.w_ada = args.in[2]; F.b_ada = args.in[3]; F.g1 = args.in[4]; F.w_in = args.in[5]; F.sink = args.in[6]; F.t5 = args.in[7];
    F.rpb = args.in[8]; F.gna = args.in[9]; F.gnb = args.in[10]; F.w_out = args.in[11]; F.g2 = args.in[12]; F.w_query = args.in[13]; F.sub_keys = args.in[14];
    F.uexp = args.in[15]; F.vexp = args.in[16]; F.gfin = args.in[17]; F.out = args.out;
    F.ada = (float*)(ws + WS_ADA); F.WO = (bf16*)(ws + WS_WO); F.WQ = (bf16*)(ws + WS_WQ); F.SK = (bf16*)(ws + WS_SK);
    F.W1A = (bf16*)(ws + WS_W1A); F.H = (bf16*)(ws + WS_H); F.WVT = (bf16*)(ws + WS_WVT); F.U8 = ws + WS_U8; F.V8 = ws + WS_V8; F.X8 = ws + WS_X8; F.SU = (float*)(ws + WS_SU); F.SV = (float*)(ws + WS_SV); F.SX = (float*)(ws + WS_SX); F.ctl = (unsigned*)(ws + WS_CTL); F.X1 = (bf16*)(ws + WS_X1);
    F.PROJ = (bf16*)(ws + WS_PROJ); F.VT = (bf16*)(ws + WS_VT); F.QP = (bf16*)(ws + WS_QP); F.MIX = (bf16*)(ws + WS_MIX); F.IDX = (int*)(ws + WS_IDX); F.GT = (float*)(ws + WS_G);

    volatile LAS unsigned* MISC = (volatile LAS unsigned*)(F.lds + MISC_OFF); F.MISC = MISC;
    if (F.tid < 32) MISC[F.tid] = 0u;
    __syncthreads();
    XcdBarrier bar = xcd_barrier_post((unsigned*)(ws + WS_CTL) + CW_BAR, MISC + 8);

    p0_prologue(F);
    if (F.tid == 0) {
        unsigned sp = 0;
        while (__hip_atomic_load(F.ctl + CW_ADA, __ATOMIC_RELAXED, __HIP_MEMORY_SCOPE_AGENT) < 32u) { __builtin_amdgcn_s_sleep(2); if (++sp > (1u << 22)) break; }
        __builtin_amdgcn_fence(__ATOMIC_ACQUIRE, "agent");
        asm volatile("s_waitcnt vmcnt(0)" ::: "memory");
    }
    __syncthreads();
    {
        const int rpw = M / F.ngw, mb = F.gw * rpw; const float* ad = F.ada + (size_t)(mb >> 13) * 6144;
        int ln = F.lane; asm volatile("" : "+v"(ln));
        f32x4 gs[4], sh[4]; load_mod_vectors(gs, sh, F.g1, ad, ad + 1024, ln);
        for (int k = 0; k < rpw; k += 2) {
#pragma unroll
            for (int u = 0; u < 2; ++u) { const int m = mb + k + u; norm_mod_row<false, float>(F.x + (size_t)m * D, F.H + (size_t)m * D, gs, sh, ln); } }
    }
    xcd_barrier(bar);
    { pg8::Gemm g{F.H, F.W1A, M + NVT, N1A + M, D, D, D}; pg8::Gemm1Order So; So.init(F.G, F.bx);
      pg8::EpiGemm1 E{pg8::EpiQKFrag{F.PROJ, M}, pg8::EpiVTFrag{F.VT, M}};
      pg8::gemm_phase<pg8::EpiGemm1, pg8::Gemm1Order, true, true>(F.lds, g, So, E); }
    xcd_barrier(bar);
    attn_phase(F);
    xcd_barrier(bar);
    { pg8::Gemm g{F.MIX, F.WO, M, D, D, D, D}; pg8::StaticOrder So; So.init(M, D, F.G, F.bx); pg8::EpiResGate E{F.x, F.ada, F.X1};
      pg8::gemm_phase<pg8::EpiResGate, pg8::StaticOrder, true, true>(F.lds, g, So, E); }
    xcd_barrier(bar);
    {
        const int rpw = M / F.ngw, mb = F.gw * rpw; const float* ad = F.ada + (size_t)(mb >> 13) * 6144;
        int ln = F.lane; asm volatile("" : "+v"(ln));
        f32x4 gs[4], sh[4]; load_mod_vectors(gs, sh, F.g2, ad + 3072, ad + 4096, ln);
        for (int k = 0; k < rpw; k += 2) {
#pragma unroll
            for (int u = 0; u < 2; ++u) { const int m = mb + k + u; norm_mod_row<true, bf16>(F.X1 + (size_t)m * D, F.H + (size_t)m * D, gs, sh, ln, F.X8 + (size_t)m * D, F.SX + m); } }
    }
    xcd_barrier(bar);
    { pg8::Gemm g{F.H, F.WQ, M, NQ, D, D, D}; pg8::StaticOrder So; So.init(M, NQ, F.G, F.bx); pg8::EpiQKFrag E{F.QP, M};
      pg8::gemm_phase<pg8::EpiQKFrag, pg8::StaticOrder, true, true>(F.lds, g, So, E); }
    xcd_barrier(bar);
    route_phase(F);
    xcd_barrier(bar);
    peer_fused_phase(F, F.MIX);
}

extern "C" void kernel_launch(void* const* d_in, const int* in_sizes, int n_in, void* d_out, int out_size, void* d_ws, size_t ws_size, hipStream_t stream) {
    static int grid = 0;
    if (grid == 0) {
        if (n_in != 18 || out_size != M * D || ws_size < WS_END) { fprintf(stderr, "kernel_launch: unexpected shapes (n_in %d out %d ws %zu)\n", n_in, out_size, ws_size); grid = -1; return; }
        int dev = 0, cus = 0, per_cu = 0;
        if (hipGetDevice(&dev) != hipSuccess || hipDeviceGetAttribute(&cus, hipDeviceAttributeMultiprocessorCount, dev) != hipSuccess) { grid = -1; return; }
        if (hipFuncSetAttribute((const void*)hymba_fwd, hipFuncAttributeMaxDynamicSharedMemorySize, LDS_BYTES) != hipSuccess) { fprintf(stderr, "kernel_launch: hipFuncSetAttribute failed\n"); grid = -1; return; }
        if (hipOccupancyMaxActiveBlocksPerMultiprocessor(&per_cu, (const void*)hymba_fwd, NTHREADS, LDS_BYTES) != hipSuccess || per_cu < 1) { fprintf(stderr, "kernel_launch: occupancy query says %d\n", per_cu); per_cu = 1; }
        (void)hipGetLastError();
        grid = cus;
    }
    if (grid < 0) return;
    if (hipMemsetAsync((char*)d_ws + WS_CTL, 0, CTL_ZERO_BYTES, stream) != hipSuccess) return;
    Args a{};
    for (int i = 0; i < 18; ++i) a.in[i] = (const float*)d_in[i];
    a.out = (float*)d_out; a.ws = (unsigned char*)d_ws;
    hipLaunchKernelGGL(hymba_fwd, dim3(grid), dim3(NTHREADS), LDS_BYTES, stream, a);
}
```

```cpp
#include <hip/hip_runtime.h>
#include <cstdio>
#include <cstdint>

#define GAS __attribute__((address_space(1)))
#define LAS __attribute__((address_space(3)))
typedef unsigned short bf16;
typedef unsigned v4u __attribute__((ext_vector_type(4)));
typedef unsigned v2u __attribute__((ext_vector_type(2)));
typedef float f32x4 __attribute__((ext_vector_type(4)));
typedef float f32x16 __attribute__((ext_vector_type(16)));
typedef short bf16x8 __attribute__((ext_vector_type(8)));
typedef __bf16 bf16x2v __attribute__((ext_vector_type(2)));

#define MFMA32(a, b, c) __builtin_amdgcn_mfma_f32_32x32x16_bf16((a), (b), (c), 0, 0, 0)
#define LDS_WAIT() asm volatile("s_waitcnt lgkmcnt(0)" ::: "memory")

constexpr int NB = 4, S = 8192, D = 1024, M = NB * S;
constexpr int N1A = 1792;
constexpr int NVT = 768;
constexpr int NQ = 2048;
constexpr int NEXP = 16384;
constexpr float EPS = 1e-6f;
constexpr int NWAVES = 8, NTHREADS = 512;

constexpr size_t MiB = 1u << 20;
constexpr size_t WS_CTL = 0, CTL_ZERO_BYTES = 64 * 1024;
constexpr size_t WS_ADA = 1 * MiB;
constexpr size_t WS_WO = 2 * MiB;
constexpr size_t WS_WQ = 4 * MiB;
constexpr size_t WS_SK = 8 * MiB;
constexpr size_t WS_WBIG = 10 * MiB;
constexpr size_t WS_W1A = WS_WBIG, WS_H = WS_WBIG + (size_t)N1A * D * 2, WS_WVT = WS_H + (size_t)M * D * 2;
constexpr size_t WS_SU = 1 * MiB + 256 * 1024, WS_SV = 1 * MiB + 512 * 1024, WS_SX = 1 * MiB + 768 * 1024;
constexpr size_t WS_U8 = 80 * MiB, WS_V8 = 96 * MiB;
constexpr size_t WS_X8 = 112 * MiB;
constexpr size_t WS_PROJ = 144 * MiB;
constexpr size_t WS_VT = 256 * MiB;
constexpr size_t WS_QP = 144 * MiB;
constexpr size_t WS_MIX = 306 * MiB;
constexpr size_t WS_IDX = 372 * MiB;
constexpr size_t WS_G = 388 * MiB;
constexpr size_t WS_X1 = 416 * MiB;
constexpr size_t WS_END = 480 * MiB;
static_assert(WS_VT + (size_t)NVT * M * 2 <= WS_MIX, "ws map");
static_assert(WS_WVT + (size_t)NVT * D * 2 <= WS_U8 && WS_X8 + (size_t)M * D <= WS_PROJ, "ws map");
static_assert(WS_QP + (size_t)M * NQ * 2 <= WS_MIX, "ws map");
constexpr int CW_BAR = 4096;
constexpr int CW_ADA = 12288;

static_assert((12288 + 64) * 4 <= (int)CTL_ZERO_BYTES && (4096 + 3456) * 4 <= (int)CTL_ZERO_BYTES, "control words inside the per-call memset");
constexpr int LDS_BYTES = 147456;
constexpr int MISC_OFF = 131072 + 320;

typedef float f32x2v __attribute__((ext_vector_type(2)));
__device__ __forceinline__ unsigned pk2(float lo, float hi) { f32x2v v; v.x = lo; v.y = hi; return __builtin_bit_cast(unsigned, __builtin_convertvector(v, bf16x2v)); }
__device__ __forceinline__ float bflo(unsigned w) { return __builtin_bit_cast(float, w << 16); }
__device__ __forceinline__ float bfhi(unsigned w) { return __builtin_bit_cast(float, w & 0xffff0000u); }
constexpr int DPP_XOR1 = 0xB1, DPP_XOR2 = 0x4E, DPP_ROR4 = 0x124, DPP_ROR8 = 0x128;
template <int CTRL> __device__ __forceinline__ float dppf(float x) { return __builtin_bit_cast(float, __builtin_amdgcn_mov_dpp(__builtin_bit_cast(int, x), CTRL, 0xf, 0xf, true)); }
template <int CTRL> __device__ __forceinline__ int dppi(int x) { return __builtin_amdgcn_mov_dpp(x, CTRL, 0xf, 0xf, true); }
__device__ __forceinline__ void halves(float x, float& lo, float& hi) {
    auto t = __builtin_amdgcn_permlane32_swap(__builtin_bit_cast(unsigned, x), __builtin_bit_cast(unsigned, x), false, false);
    const unsigned a = t[0], b = t[1];
    lo = __builtin_bit_cast(float, a); hi = __builtin_bit_cast(float, b);
}
__device__ __forceinline__ float xhalf_max(float x) { float a, b; halves(x, a, b); return fmaxf(a, b); }
__device__ __forceinline__ float xhalf_sum(float x) { float a, b; halves(x, a, b); return a + b; }
__device__ __forceinline__ float wave_sum(float v) {
    v += dppf<DPP_XOR1>(v); v += dppf<DPP_XOR2>(v); v += dppf<DPP_ROR4>(v); v += dppf<DPP_ROR8>(v);
    auto s = __builtin_amdgcn_permlane16_swap(__builtin_bit_cast(unsigned, v), __builtin_bit_cast(unsigned, v), false, false);
    const unsigned s0 = s[0], s1 = s[1];
    v = __builtin_bit_cast(float, s0) + __builtin_bit_cast(float, s1);
    return xhalf_sum(v);
}
__device__ __forceinline__ float wave_max(float v) {
    v = fmaxf(v, dppf<DPP_XOR1>(v)); v = fmaxf(v, dppf<DPP_XOR2>(v)); v = fmaxf(v, dppf<DPP_ROR4>(v)); v = fmaxf(v, dppf<DPP_ROR8>(v));
    auto s = __builtin_amdgcn_permlane16_swap(__builtin_bit_cast(unsigned, v), __builtin_bit_cast(unsigned, v), false, false);
    const unsigned s0 = s[0], s1 = s[1];
    v = fmaxf(__builtin_bit_cast(float, s0), __builtin_bit_cast(float, s1));
    return xhalf_max(v);
}
__device__ __forceinline__ unsigned q8(float v, float inv, int bias) {
    float q = rintf(v * inv); q = fminf(fmaxf(q, -127.f), 127.f);
    return (unsigned)((int)q + bias) & 0xffu;
}
__device__ __forceinline__ unsigned q8x4(const f32x4& v, float inv, int bias) { return q8(v.x, inv, bias) | (q8(v.y, inv, bias) << 8) | (q8(v.z, inv, bias) << 16) | (q8(v.w, inv, bias) << 24); }
__device__ __forceinline__ int crow(int i, int h) { return (i & 3) + 8 * (i >> 2) + 4 * h; }

#define XB_TMO      128
#define XB_XCNT(j)  (256  + 64 * (j))
#define XB_XSUB(j)  (1280 + 64 * (j))
#define XB_XGEN(j)  (2304 + 64 * (j))
#define XB_TOP      3328
#define XB_TOPGEN   3392
#define XCD_BAR_WORDS 3456
#define XB_SPIN_CAP (1u << 18)

__device__ __forceinline__ unsigned xb_ld(unsigned* p)              { return __hip_atomic_load(p, __ATOMIC_RELAXED, __HIP_MEMORY_SCOPE_AGENT); }
__device__ __forceinline__ unsigned xb_add(unsigned* p, unsigned v) { return __hip_atomic_fetch_add(p, v, __ATOMIC_RELAXED, __HIP_MEMORY_SCOPE_AGENT); }
__device__ __forceinline__ unsigned xb_xcc_id() { return (unsigned)__builtin_amdgcn_s_getreg((3 << 11) | 20) & 0xFu; }
#define XB_SPIN(cond, bar) do { unsigned _sp = 0; while (cond) { __builtin_amdgcn_s_sleep(1); \
    if ((++_sp & 255u) == 0u) { if (xb_ld(&(bar)[XB_TMO])) break; if (_sp > XB_SPIN_CAP) { atomicAdd(&(bar)[XB_TMO], 1u); break; } } } } while (0)

struct XcdBarrier {
    unsigned* bar; unsigned x;
    volatile LAS unsigned* st;
};
__device__ __forceinline__ XcdBarrier xcd_barrier_post(unsigned* bar, volatile LAS unsigned* st) {
    XcdBarrier b; b.bar = bar; b.x = xb_xcc_id(); b.st = st;
    if (threadIdx.x == 0) (void)xb_add(&bar[XB_XCNT(b.x)], 1u);
    return b;
}
__device__ __forceinline__ void xcd_barrier_complete(unsigned* bar, unsigned x, unsigned& nloc, unsigned& nx) {
    const unsigned G = gridDim.x * gridDim.y * gridDim.z;
    unsigned sum, cnt, mine, sp = 0u;
    for (;;) {
        sum = 0u; cnt = 0u; mine = 0u;
#pragma unroll
        for (unsigned j = 0; j < 16; ++j) { const unsigned c = xb_ld(&bar[XB_XCNT(j)]); sum += c; cnt += (c > 0u) ? 1u : 0u; mine = (j == x) ? c : mine; }
        if (sum == G) break;
        __builtin_amdgcn_s_sleep(1);
        if ((++sp & 255u) == 0u) { if (xb_ld(&bar[XB_TMO])) break; if (sp > XB_SPIN_CAP) { atomicAdd(&bar[XB_TMO], 1u); break; } }
    }
    nloc = mine > 0u ? mine : 1u; nx = cnt > 0u ? cnt : 1u;
}
__device__ __forceinline__ void xcd_barrier(const XcdBarrier& b) {
    asm volatile("s_waitcnt vmcnt(0)" ::: "memory");
    __syncthreads();
    if (threadIdx.x == 0) {
        unsigned* bar = b.bar;
        __builtin_amdgcn_s_waitcnt(0);
        unsigned nloc = b.st[0], nx = b.st[1];
        if (nloc == 0u) { xcd_barrier_complete(bar, b.x, nloc, nx); b.st[0] = nloc; b.st[1] = nx; }
        const unsigned old = xb_add(&bar[XB_XSUB(b.x)], 1u);
        const unsigned gen = old / nloc;
        if (old + 1u == (gen + 1u) * nloc) {
            __builtin_amdgcn_fence(__ATOMIC_RELEASE, "agent");
            asm volatile("s_waitcnt vmcnt(0)" ::: "memory");
            const unsigned og = xb_add(&bar[XB_TOP], 1u);
            const unsigned tg = og / nx;
            if (og + 1u == (tg + 1u) * nx) xb_add(&bar[XB_TOPGEN], 1u);
            else XB_SPIN(xb_ld(&bar[XB_TOPGEN]) == tg, bar);
            __builtin_amdgcn_fence(__ATOMIC_ACQUIRE, "agent");
            xb_add(&bar[XB_XGEN(b.x)], 1u);
            asm volatile("s_waitcnt vmcnt(0)" ::: "memory");
        } else {
            XB_SPIN(xb_ld(&bar[XB_XGEN(b.x)]) == gen, bar);
            __builtin_amdgcn_fence(__ATOMIC_ACQUIRE, "agent");
            asm volatile("s_waitcnt vmcnt(0)" ::: "memory");
        }
    }
    __syncthreads();
}

namespace pg8 {
#define PG8_LAS __attribute__((address_space(3)))
typedef unsigned short bf16_t;
typedef short bf16x8 __attribute__((ext_vector_type(8)));
typedef float f32x4 __attribute__((ext_vector_type(4)));
typedef unsigned u32x4 __attribute__((ext_vector_type(4)));
constexpr int BM = 256, BK = 64, HALF = 128, HTB = HALF * BK * 2  , STAGE_BYTES = 8 * HTB, NXCD = 8, WGM = 8;

__host__ __device__ __forceinline__ int lds_byte(int r, int c) { const int st = (r >> 4) * 2 + (c >> 5), rr = r & 15, cc = c & 31, ob = rr * 64 + cc * 2; return st * 1024 + (ob ^ (((ob >> 9) & 1) << 5)); }
__host__ __device__ __forceinline__ void stage_rc(int b, int& R, int& C) { const int st = b / 1024, sb = b % 1024, swz = sb ^ (((sb >> 9) & 1) << 5); R = (st >> 1) * 16 + swz / 64; C = (st & 1) * 32 + (swz % 64) / 2; }
__host__ __device__ __forceinline__ int perm32(int rho) { const int n = rho >> 4, i = rho & 15; return 8 * (i >> 2) + 4 * n + (i & 3); }

struct Unit { int pm, pn; };
struct Gemm { const bf16_t* A; const bf16_t* Bt; int M, N, K, lda, ldb; };

struct StaticOrder {
    int nM, nN, nwg, G, c;
    __host__ __device__ void init(int M, int N, int G_, int c_) { nM = M / BM; nN = N / BM; nwg = nM * nN; G = G_; c = c_; }
    __host__ __device__ bool next(int i, Unit& u) const {
        const long L = (long)i * G + c; if (L >= nwg) return false;
        int wgid = (int)L; { const int q = nwg / NXCD, r = nwg % NXCD, xcd = wgid % NXCD, off = wgid / NXCD; wgid = (xcd < r ? xcd * (q + 1) : r * (q + 1) + (xcd - r) * q) + off; }
        const int nig = WGM * nN, gid = wgid / nig, fm = gid * WGM, gsz = (nM - fm) < WGM ? (nM - fm) : WGM;
        u.pm = fm + ((wgid % nig) % gsz); u.pn = (wgid % nig) / gsz; return true;
    }
    __device__ __forceinline__ void a_ready(const Unit&) const {}
    __device__ __forceinline__ void done(const Unit&) const {}
};
struct Gemm1Order {
    StaticOrder a, b; int G, c;
    __host__ __device__ void init(int G_, int c_) { G = G_; c = c_; a.init(32768, 1792, G_, 0); b.init(768, 32768, G_, 0); }
    __host__ __device__ bool next(int i, Unit& u) const {
        const long L = (long)i * G + c;
        if (L < a.nwg) { StaticOrder t = a; t.G = 1; t.c = 0; return t.next((int)L, u); }
        if (L < a.nwg + b.nwg) { StaticOrder t = b; t.G = 1; t.c = 0; t.next((int)(L - a.nwg), u); u.pm += 128; u.pn += 7; return true; }
        return false;
    }
    __device__ __forceinline__ void a_ready(const Unit&) const {}
    __device__ __forceinline__ void done(const Unit&) const {}
};


__device__ __forceinline__ unsigned cvt_pk_bf16(float lo, float hi) { unsigned r; asm volatile("v_cvt_pk_bf16_f32 %0, %1, %2" : "=v"(r) : "v"(lo), "v"(hi)); return r; }
struct EpiQKFrag {
    static constexpr bool PERM = true, AFTER_DRAIN = false;
    bf16_t* O; int Mtok;
    __device__ __forceinline__ void operator()(const f32x4 (&acc)[2][2][4][2], const Unit& u, int wr, int wc, int fr, int fq) const {
        const int row0 = u.pm * BM + wr * 64 + fr, col0 = u.pn * BM + wc * 32 + 8 * fq;
#pragma unroll
        for (int ai = 0; ai < 2; ++ai)
#pragma unroll
            for (int m = 0; m < 4; ++m) { const int row = row0 + ai * HALF + m * 16;
#pragma unroll
                for (int bj = 0; bj < 2; ++bj) { const int c = col0 + bj * HALF, hb = c >> 6, d0 = c & 63;
                    const f32x4 v0 = acc[ai][bj][m][0], v1 = acc[ai][bj][m][1];
                    u32x4 w; w.x = cvt_pk_bf16(v0[0], v0[1]); w.y = cvt_pk_bf16(v0[2], v0[3]); w.z = cvt_pk_bf16(v1[0], v1[1]); w.w = cvt_pk_bf16(v1[2], v1[3]);
                    *(u32x4*)(O + (size_t)hb * Mtok * 64 + (size_t)(row >> 5) * 2048 + (d0 >> 3) * 256 + (row & 31) * 8) = w; } }
    }
};
struct EpiVTFrag {
    static constexpr bool PERM = true, AFTER_DRAIN = false;
    bf16_t* O; int Mtok;
    __device__ __forceinline__ void operator()(const f32x4 (&acc)[2][2][4][2], const Unit& u, int wr, int wc, int fr, int fq) const {
        typedef unsigned u32x2 __attribute__((ext_vector_type(2)));
        const int row0 = u.pm * BM + wr * 64 + fr, col0 = u.pn * BM + wc * 32 + 8 * fq;
#pragma unroll
        for (int ai = 0; ai < 2; ++ai)
#pragma unroll
            for (int m = 0; m < 4; ++m) { const int vrow = row0 + ai * HALF + m * 16, vb = vrow >> 6, dt = (vrow >> 5) & 1, r = vrow & 31;
#pragma unroll
                for (int bj = 0; bj < 2; ++bj) { const int t0 = col0 + bj * HALF, k0 = t0 & 31, sk = k0 >> 4, half = (k0 >> 3) & 1;
                    const f32x4 v0 = acc[ai][bj][m][0], v1 = acc[ai][bj][m][1];
                    bf16_t* base = O + (size_t)vb * Mtok * 64 + (size_t)(t0 >> 5) * 2048 + ((dt * 2 + sk) * 2) * 256 + r * 8 + 4 * half;
                    u32x2 lo, hi; lo.x = cvt_pk_bf16(v0[0], v0[1]); lo.y = cvt_pk_bf16(v0[2], v0[3]); hi.x = cvt_pk_bf16(v1[0], v1[1]); hi.y = cvt_pk_bf16(v1[2], v1[3]);
                    *(u32x2*)(base) = lo;
                    *(u32x2*)(base + 256) = hi; } }
    }
};
struct EpiGemm1 {
    static constexpr bool PERM = true, AFTER_DRAIN = false;
    EpiQKFrag qk; EpiVTFrag vt;
    __device__ __forceinline__ void operator()(const f32x4 (&acc)[2][2][4][2], const Unit& u, int wr, int wc, int fr, int fq) const {
        if (u.pm < 128) qk(acc, u, wr, wc, fr, fq);
        else { Unit v; v.pm = u.pm - 128; v.pn = u.pn - 7; vt(acc, v, wr, wc, fr, fq); }
    }
};
struct EpiResGate {
    static constexpr bool PERM = true, AFTER_DRAIN = false;
    const float* x; const float* ada; bf16_t* out;
    __device__ __forceinline__ void operator()(const f32x4 (&acc)[2][2][4][2], const Unit& u, int wr, int wc, int fr, int fq) const {
        const int row0 = u.pm * BM + wr * 64 + fr, col0 = u.pn * BM + wc * 32 + 8 * fq;
        const float* gate = ada + (size_t)((u.pm * BM) >> 13) * 6144 + 2048;
        f32x4 gv[2][2];
#pragma unroll
        for (int bj = 0; bj < 2; ++bj)
#pragma unroll
            for (int n = 0; n < 2; ++n) gv[bj][n] = *(const f32x4*)(gate + col0 + bj * HALF + 4 * n);
#pragma unroll
        for (int ai = 0; ai < 2; ++ai) {
            f32x4 xv[4][2][2];
#pragma unroll
            for (int m = 0; m < 4; ++m) { const size_t off = (size_t)(row0 + ai * HALF + m * 16) * 1024 + col0;
#pragma unroll
                for (int bj = 0; bj < 2; ++bj) { xv[m][bj][0] = __builtin_nontemporal_load((const f32x4*)(x + off + bj * HALF)); xv[m][bj][1] = __builtin_nontemporal_load((const f32x4*)(x + off + bj * HALF + 4)); } }
            __builtin_amdgcn_sched_barrier(0);
#pragma unroll
            for (int m = 0; m < 4; ++m) { const size_t off = (size_t)(row0 + ai * HALF + m * 16) * 1024 + col0;
#pragma unroll
                for (int bj = 0; bj < 2; ++bj) {
                    const f32x4 v0 = xv[m][bj][0] + gv[bj][0] * acc[ai][bj][m][0], v1 = xv[m][bj][1] + gv[bj][1] * acc[ai][bj][m][1];
                    u32x4 w; w.x = cvt_pk_bf16(v0[0], v0[1]); w.y = cvt_pk_bf16(v0[2], v0[3]); w.z = cvt_pk_bf16(v1[0], v1[1]); w.w = cvt_pk_bf16(v1[2], v1[3]);
                    *(u32x4*)(out + off + bj * HALF) = w; } }
            __builtin_amdgcn_sched_barrier(0);
        }
    }
};

template <class Epi, class Sched, bool ALIGN_EPI = false, bool SP2 = false>
__device__ __forceinline__ void gemm_phase(PG8_LAS unsigned char* lds, const Gemm g, const Sched& S, const Epi& E) {
    int tid = threadIdx.x; asm volatile("" : "+v"(tid));
    const int wid = __builtin_amdgcn_readfirstlane(tid >> 6), lane = tid & 63, wr = wid >> 2, wc = wid & 3, fr = lane & 15, fq = lane >> 4;
    const int K = g.K, nt = K / BK;
    unsigned voffA[2], voffB[2];
#pragma unroll
    for (int i = 0; i < 2; ++i) { int R, C; stage_rc(tid * 16 + i * 8192, R, C); const int Rb = Epi::PERM ? ((R & ~31) + perm32(R & 31)) : R;
        voffA[i] = (unsigned)(R * g.lda + C) * 2u; voffB[i] = (unsigned)(Rb * g.ldb + C) * 2u; }
    const size_t kstep = (size_t)(BK * 2);
    const size_t hstepA = (size_t)HALF * g.lda * 2, hstepB = (size_t)HALF * g.ldb * 2;
    const size_t tstepA = 2 * hstepA, tstepB = 2 * hstepB;
    const unsigned ldsw = (unsigned)wid * 1024u;
    const int aoff = lds_byte(wr * 64 + fr, fq * 8), boff = lds_byte(wc * 32 + fr, fq * 8);
#define PG8_SA(b, h) (((b) * 2 + (h)) * HTB)
#define PG8_SB(b, h) ((4 + (b) * 2 + (h)) * HTB)
#define PG8_STAGE(bufoff, gbase, voff) do { _Pragma("unroll") for (int _i = 0; _i < 2; ++_i) \
        __builtin_amdgcn_global_load_lds((const unsigned*)((const char*)(gbase) + (voff)[_i]), (PG8_LAS unsigned*)(lds + (bufoff) + ldsw + _i * 8192), 16, 0, 0); } while (0)
#define PG8_LDA(dst, b, h) do { _Pragma("unroll") for (int m = 0; m < 4; ++m) _Pragma("unroll") for (int k = 0; k < 2; ++k) dst[m][k] = *(const PG8_LAS bf16x8*)(lds + PG8_SA(b, h) + aoff + m * 2048 + k * 1024); } while (0)
#define PG8_LDB(dst, b, h) do { _Pragma("unroll") for (int n = 0; n < 2; ++n) _Pragma("unroll") for (int k = 0; k < 2; ++k) dst[n][k] = *(const PG8_LAS bf16x8*)(lds + PG8_SB(b, h) + boff + n * 2048 + k * 1024); } while (0)
#define PG8_MMA(ai, bj, At, Bt) do { __builtin_amdgcn_s_setprio(1); _Pragma("unroll") for (int m = 0; m < 4; ++m) _Pragma("unroll") for (int n = 0; n < 2; ++n) _Pragma("unroll") for (int k = 0; k < 2; ++k) \
        acc[ai][bj][m][n] = __builtin_amdgcn_mfma_f32_16x16x32_bf16(Bt[n][k], At[m][k], acc[ai][bj][m][n], 0, 0, 0); __builtin_amdgcn_s_setprio(0); } while (0)
#define PG8_WAIT_V(n) asm volatile("s_waitcnt vmcnt(" #n ")" ::: "memory")
#define PG8_WAIT_L(n) asm volatile("s_waitcnt lgkmcnt(" #n ")" ::: "memory")
#define PG8_BAR __builtin_amdgcn_s_barrier()
#define PG8_SCHED __builtin_amdgcn_sched_barrier(0)
    Unit cur, nxt; int ui = 0;
    if (!S.next(0, cur)) return;
    f32x4 acc[2][2][4][2];
#pragma unroll
    for (int a = 0; a < 2; ++a)
#pragma unroll
        for (int b = 0; b < 2; ++b)
#pragma unroll
            for (int m = 0; m < 4; ++m)
#pragma unroll
                for (int n = 0; n < 2; ++n) acc[a][b][m][n] = (f32x4){0.f, 0.f, 0.f, 0.f};
    bf16x8 At[4][2], B0[2][2], B1[2][2];
    const char* cA = (const char*)g.A + (size_t)cur.pm * tstepA; const char* cB = (const char*)g.Bt + (size_t)cur.pn * tstepB;
    S.a_ready(cur);
    if constexpr (SP2) {
        PG8_STAGE(PG8_SB(0, 0), cB, voffB); PG8_STAGE(PG8_SB(0, 1), cB + hstepB, voffB); PG8_STAGE(PG8_SA(0, 0), cA, voffA); PG8_STAGE(PG8_SA(0, 1), cA + hstepA, voffA);
        if (wr == 1) PG8_BAR;
        PG8_WAIT_V(2); PG8_BAR;
        PG8_STAGE(PG8_SB(1, 0), cB + kstep, voffB); PG8_STAGE(PG8_SA(1, 0), cA + kstep, voffA); PG8_STAGE(PG8_SB(1, 1), cB + hstepB + kstep, voffB);
        PG8_WAIT_V(6); PG8_BAR;
    } else {
        PG8_STAGE(PG8_SB(0, 0), cB, voffB); PG8_STAGE(PG8_SA(0, 0), cA, voffA); PG8_STAGE(PG8_SB(0, 1), cB + hstepB, voffB); PG8_STAGE(PG8_SA(0, 1), cA + hstepA, voffA);
        if (wr == 1) PG8_BAR;
        PG8_WAIT_V(4); PG8_BAR;
        PG8_STAGE(PG8_SB(1, 0), cB + kstep, voffB); PG8_STAGE(PG8_SA(1, 0), cA + kstep, voffA); PG8_STAGE(PG8_SB(1, 1), cB + hstepB + kstep, voffB);
        PG8_WAIT_V(6); PG8_BAR;
    }
    for (;;) {
        const bool has_next = S.next(ui + 1, nxt);
        const char* nA = has_next ? (const char*)g.A + (size_t)nxt.pm * tstepA : cA; const char* nB = has_next ? (const char*)g.Bt + (size_t)nxt.pn * tstepB : cB;
        for (int t = 0; t < nt; t += 2) {
            const bool last = (t == nt - 2);
            const char* a1 = cA + (size_t)(t + 1) * kstep;
            const char* a2 = last ? nA : cA + (size_t)(t + 2) * kstep; const char* b2 = last ? nB : cB + (size_t)(t + 2) * kstep;
            const char* a3 = a2 + kstep; const char* b3 = b2 + kstep;
            if (last && has_next) S.a_ready(nxt);
            if constexpr (SP2) {
            PG8_LDB(B0, 0, 0); PG8_LDB(B1, 0, 1); PG8_SCHED; PG8_LDA(At, 0, 0); PG8_STAGE(PG8_SA(1, 1), a1 + hstepA, voffA);
            PG8_WAIT_V(8); PG8_WAIT_L(0); PG8_BAR; PG8_MMA(0, 0, At, B0); PG8_MMA(0, 1, At, B1); PG8_BAR; PG8_SCHED;
            PG8_LDA(At, 0, 1); PG8_STAGE(PG8_SB(0, 0), b2, voffB); PG8_STAGE(PG8_SB(0, 1), b2 + hstepB, voffB); PG8_STAGE(PG8_SA(0, 0), a2, voffA);
            PG8_WAIT_V(8); PG8_WAIT_L(0); PG8_BAR; PG8_MMA(1, 0, At, B0); PG8_MMA(1, 1, At, B1); PG8_BAR; PG8_SCHED;
            PG8_LDB(B0, 1, 0); PG8_LDB(B1, 1, 1); PG8_SCHED; PG8_LDA(At, 1, 0); PG8_STAGE(PG8_SA(0, 1), a2 + hstepA, voffA);
            PG8_WAIT_V(8); PG8_WAIT_L(0); PG8_BAR; PG8_MMA(0, 0, At, B0); PG8_MMA(0, 1, At, B1); PG8_BAR; PG8_SCHED;
            PG8_LDA(At, 1, 1); PG8_STAGE(PG8_SB(1, 0), b3, voffB); PG8_STAGE(PG8_SB(1, 1), b3 + hstepB, voffB); PG8_STAGE(PG8_SA(1, 0), a3, voffA);
            PG8_WAIT_V(8); PG8_WAIT_L(0); PG8_BAR; PG8_MMA(1, 0, At, B0); PG8_MMA(1, 1, At, B1); PG8_BAR; PG8_SCHED;
            } else {
            PG8_LDB(B0, 0, 0); PG8_SCHED; PG8_LDA(At, 0, 0); PG8_STAGE(PG8_SA(1, 1), a1 + hstepA, voffA);
            PG8_WAIT_L(8); PG8_BAR; PG8_WAIT_L(0); PG8_MMA(0, 0, At, B0); PG8_BAR; PG8_SCHED;
            PG8_LDB(B1, 0, 1); PG8_STAGE(PG8_SB(0, 0), b2, voffB);
            PG8_BAR; PG8_WAIT_L(0); PG8_MMA(0, 1, At, B1); PG8_BAR;
            PG8_LDA(At, 0, 1); PG8_STAGE(PG8_SA(0, 0), a2, voffA);
            PG8_BAR; PG8_WAIT_L(0); PG8_MMA(1, 0, At, B0); PG8_BAR; PG8_SCHED;
            PG8_STAGE(PG8_SB(0, 1), b2 + hstepB, voffB);
            PG8_WAIT_V(6); PG8_BAR; PG8_MMA(1, 1, At, B1); PG8_BAR;
            PG8_LDB(B0, 1, 0); PG8_SCHED; PG8_LDA(At, 1, 0); PG8_STAGE(PG8_SA(0, 1), a2 + hstepA, voffA);
            PG8_WAIT_L(8); PG8_BAR; PG8_WAIT_L(0); PG8_MMA(0, 0, At, B0); PG8_BAR; PG8_SCHED;
            PG8_LDB(B1, 1, 1); PG8_STAGE(PG8_SB(1, 0), b3, voffB);
            PG8_BAR; PG8_WAIT_L(0); PG8_MMA(0, 1, At, B1); PG8_BAR;
            PG8_LDA(At, 1, 1); PG8_STAGE(PG8_SA(1, 0), a3, voffA);
            PG8_BAR; PG8_WAIT_L(0); PG8_MMA(1, 0, At, B0); PG8_BAR; PG8_SCHED;
            PG8_STAGE(PG8_SB(1, 1), b3 + hstepB, voffB);
            PG8_WAIT_V(6); PG8_BAR; PG8_MMA(1, 1, At, B1); PG8_BAR;
            }
        }
        if constexpr (ALIGN_EPI) { if (wr == 0) PG8_BAR; }
        if constexpr (!Epi::AFTER_DRAIN) { E(acc, cur, wr, wc, fr, fq); S.done(cur); }
        if (!has_next) break;
#pragma unroll
        for (int a = 0; a < 2; ++a)
#pragma unroll
            for (int b = 0; b < 2; ++b)
#pragma unroll
                for (int m = 0; m < 4; ++m)
#pragma unroll
                    for (int n = 0; n < 2; ++n) acc[a][b][m][n] = (f32x4){0.f, 0.f, 0.f, 0.f};
        cur = nxt; cA = nA; cB = nB; ++ui;
        if constexpr (ALIGN_EPI) { if (wr == 1) PG8_BAR; }
    }
    PG8_WAIT_V(0);
    if constexpr (!ALIGN_EPI) { if (wr == 0) PG8_BAR; }
    PG8_BAR;
    if constexpr (Epi::AFTER_DRAIN) { E.fused(acc, cur, wr, wc, fr, fq, lds, wid, lane); S.done(cur); }
#undef PG8_SA
#undef PG8_SB
#undef PG8_STAGE
#undef PG8_LDA
#undef PG8_LDB
#undef PG8_MMA
#undef PG8_WAIT_V
#undef PG8_WAIT_L
#undef PG8_BAR
#undef PG8_SCHED
}
}

struct Args { const float* in[18]; float* out; unsigned char* ws; };
struct Frame {
    LAS unsigned char* lds;
    int tid, lane, wave, G, bx, gw, ngw;
    const float *x, *c, *w_ada, *b_ada, *g1, *w_in, *sink, *t5, *rpb, *gna, *gnb, *w_out, *g2, *w_query, *sub_keys, *uexp, *vexp, *gfin;
    float* out; float* ada;
    bf16 *WO, *WQ, *SK, *W1A, *H, *WVT, *PROJ, *VT, *QP, *MIX;
    unsigned char *U8, *V8, *X8; float *SU, *SV, *SX; unsigned* ctl; volatile LAS unsigned* MISC; bf16* X1;
    int* IDX; float* GT;
};

constexpr int FAIR_OFF = 131072 + 1024;
struct Fair {
    volatile LAS unsigned *mine, *sib; unsigned prog; bool l0;
    __device__ __forceinline__ void init(const Frame& F) {
        mine = (volatile LAS unsigned*)(F.lds + FAIR_OFF) + F.wave; sib = (volatile LAS unsigned*)(F.lds + FAIR_OFF) + (F.wave ^ 4); prog = 0; l0 = F.lane == 0;
        if (l0) *mine = 0u; }
    __device__ __forceinline__ void step() {
        ++prog; if (l0) *mine = prog;
        const unsigned q = (unsigned)__builtin_amdgcn_readfirstlane((int)*sib);
        if (prog < q) __builtin_amdgcn_s_setprio(3); else if (prog > q) __builtin_amdgcn_s_setprio(0); else __builtin_amdgcn_s_setprio(1); }
    __device__ __forceinline__ void done() { __builtin_amdgcn_s_setprio(0); }
};

__device__ __forceinline__ void p0_transpose_item(const float* W, int N, bf16* WT, int K, int k0, int n0, int dst_row0, float scale, LAS float* scr, int lane) {
    {
        const int kk0 = lane >> 3, n4 = lane & 7;
        f32x4 v[8];
#pragma unroll
        for (int i = 0; i < 8; ++i) v[i] = __builtin_nontemporal_load((const f32x4*)(W + (size_t)(k0 + kk0 + 8 * i) * N + n0 + 4 * n4));
#pragma unroll
        for (int i = 0; i < 8; ++i) { LAS float* d = scr + (kk0 + 8 * i) * 33 + 4 * n4; d[0] = v[i].x * scale; d[1] = v[i].y * scale; d[2] = v[i].z * scale; d[3] = v[i].w * scale; }
    }
    LDS_WAIT(); asm volatile("" ::: "memory");
    const int c = lane & 7;
#pragma unroll
    for (int j = 0; j < 4; ++j) { const int n = (lane >> 3) + 8 * j; const LAS float* s = scr + (8 * c) * 33 + n;
        v4u o; o.x = pk2(s[0 * 33], s[1 * 33]); o.y = pk2(s[2 * 33], s[3 * 33]); o.z = pk2(s[4 * 33], s[5 * 33]); o.w = pk2(s[6 * 33], s[7 * 33]);
        *(v4u*)(WT + (size_t)(dst_row0 + n) * K + k0 + 8 * c) = o; }
    LDS_WAIT(); asm volatile("" ::: "memory");
}

__device__ __forceinline__ void p0_prologue(Frame& F) {
    {
        LAS float* sc = (LAS float*)F.lds;
        LAS float* red = (LAS float*)(F.lds + 16384);
        bool staged = false;
        for (int item = F.bx; item < 256; item += F.G) {
            const int cq = F.lane & 7, rg = F.lane >> 3; const bool live = cq < 6;
            const int i0 = F.wave * 128 + rg;
            f32x4 acc[4];
#pragma unroll
            for (int b = 0; b < 4; ++b) acc[b] = (f32x4){0.f, 0.f, 0.f, 0.f};
            const float* wp = F.w_ada + (size_t)i0 * 6144 + item * 24 + 4 * (live ? cq : 0);
            f32x4 w[16];
#pragma unroll
            for (int it = 0; it < 16; ++it) w[it] = __builtin_nontemporal_load((const f32x4*)(wp + (size_t)it * 8 * 6144));
            if (!staged) {
                for (int i = F.tid; i < 4096; i += NTHREADS) { const float cv = F.c[i]; sc[i] = cv / (1.0f + __expf(-cv)); }
                __syncthreads(); staged = true; }
#pragma unroll
            for (int it = 0; it < 16; ++it) { const int i = i0 + 8 * it;
#pragma unroll
                for (int b = 0; b < 4; ++b) acc[b] += w[it] * sc[b * 1024 + i]; }
#pragma unroll
            for (int b = 0; b < 4; ++b) {
#pragma unroll
                for (int e = 0; e < 4; ++e) { float v = acc[b][e]; v += __shfl_xor(v, 8); v += __shfl_xor(v, 16); v += __shfl_xor(v, 32); acc[b][e] = v; }
                if (rg == 0 && live) *(LAS f32x4*)(red + (F.wave * 4 + b) * 24 + 4 * cq) = acc[b];
            }
            __syncthreads();
            if (F.tid < 96) {
                const int b = F.tid / 24, col = F.tid % 24, j = item * 24 + col;
                float s = F.b_ada[j];
#pragma unroll
                for (int w8 = 0; w8 < 8; ++w8) s += red[(w8 * 4 + b) * 24 + col];
                F.ada[b * 6144 + j] = s;
            }
            asm volatile("s_waitcnt vmcnt(0)" ::: "memory");
            __syncthreads();
            if (F.tid == 0) { __builtin_amdgcn_fence(__ATOMIC_RELEASE, "agent"); asm volatile("s_waitcnt vmcnt(0)" ::: "memory");
                              __hip_atomic_fetch_add(F.ctl + CW_ADA, 1u, __ATOMIC_RELAXED, __HIP_MEMORY_SCOPE_AGENT); }
        }
        __syncthreads();
    }
    {
        LAS float* scr = (LAS float*)(F.lds + F.wave * 16384);
        constexpr int I_IN = 16 * 72, I_O = 16 * 32, I_Q = 16 * 64;
        for (int it = F.gw; it < I_IN + I_O + I_Q; it += F.ngw) {
            int r = it;
            if (r < I_IN) {
                const int kb = r / 72, nb = r % 72, n0 = 32 * nb;
                bf16* dst; int row0; float scale = 1.0f;
                if (n0 < 512) { dst = F.W1A; row0 = n0; scale = 0.125f * 1.4426950408889634f; }
                else if (n0 < 640) { dst = F.W1A; row0 = n0; }
                else if (n0 < 768) { dst = F.WVT; row0 = n0 - 640; }
                else if (n0 < 1280) { dst = F.W1A; row0 = n0 - 128; scale = 0.125f * 1.4426950408889634f; }
                else if (n0 < 1792) { dst = F.W1A; row0 = n0 - 128; }
                else { dst = F.WVT; row0 = 128 + (n0 - 1792); }
                p0_transpose_item(F.w_in, 2304, dst, D, 64 * kb, n0, row0, scale, scr, F.lane);
                continue;
            }
            r -= I_IN;
            if (r < I_O) { const int kb = r / 32, nb = r % 32; p0_transpose_item(F.w_out, 1024, F.WO, D, 64 * kb, 32 * nb, 32 * nb, 1.0f, scr, F.lane); continue; }
            r -= I_O;
            { const int kb = r / 64, nb = r % 64; p0_transpose_item(F.w_query, 2048, F.WQ, D, 64 * kb, 32 * nb, 32 * nb, 1.0f, scr, F.lane); }
        }
    }
    {
        const int gid = F.bx * NTHREADS + F.tid;
        if (gid < 16384) ((v4u*)(F.W1A + (size_t)1664 * D))[gid] = (v4u){0u, 0u, 0u, 0u};
        else if (gid < 32768) ((v4u*)(F.WVT + (size_t)640 * D))[gid - 16384] = (v4u){0u, 0u, 0u, 0u};
    }
}

struct TabCtx { const float *uexp, *vexp; unsigned char *U8, *V8; float *SU, *SV; int lane, gw, ngw; };
__device__ __forceinline__ TabCtx tab_ctx(volatile LAS unsigned* misc) {
    volatile LAS unsigned long long* q = (volatile LAS unsigned long long*)(misc + 18);
    TabCtx c; c.uexp = (const float*)q[0]; c.vexp = (const float*)q[1]; c.U8 = (unsigned char*)q[2]; c.V8 = (unsigned char*)q[3]; c.SU = (float*)q[4]; c.SV = (float*)q[5];
    c.lane = threadIdx.x & 63; c.ngw = gridDim.x * NWAVES; c.gw = blockIdx.x * NWAVES + __builtin_amdgcn_readfirstlane(threadIdx.x >> 6); return c; }
__device__ __forceinline__ void tab_load(const TabCtx& F, f32x4 (&a)[4][4], int row0) {
#pragma unroll
    for (int u = 0; u < 4; ++u) { int row = row0 + u; row = row < 2 * NEXP ? row : 2 * NEXP - 1; const bool isv = row >= NEXP; const int rr = isv ? row - NEXP : row;
        const f32x4* src = (const f32x4*)((isv ? F.vexp : F.uexp) + (size_t)rr * D) + F.lane;
        a[u][0] = __builtin_nontemporal_load(src); a[u][1] = __builtin_nontemporal_load(src + 64); a[u][2] = __builtin_nontemporal_load(src + 128); a[u][3] = __builtin_nontemporal_load(src + 192); }
}
__device__ __forceinline__ void tab_store(const TabCtx& F, f32x4 (&a)[4][4], int row0) {
#pragma unroll
    for (int u = 0; u < 4; ++u) { const int row = row0 + u; if (row >= 2 * NEXP) continue; const bool isv = row >= NEXP; const int rr = isv ? row - NEXP : row;
        float am = 0.f;
#pragma unroll
        for (int q = 0; q < 4; ++q) am = fmaxf(am, fmaxf(fmaxf(fabsf(a[u][q].x), fabsf(a[u][q].y)), fmaxf(fabsf(a[u][q].z), fabsf(a[u][q].w))));
        am = wave_max(am);
        const float inv = am > 0.f ? 127.0f / am : 0.f, scale = am * (1.0f / 127.0f);
        unsigned char* ob = (isv ? F.V8 : F.U8) + ((size_t)(F.lane >> 5) * NEXP + rr) * 128 + (F.lane & 31) * 4;
#pragma unroll
        for (int q = 0; q < 4; ++q) *(unsigned*)(ob + (size_t)(2 * q) * NEXP * 128) = q8x4(a[u][q], inv, 0);
        if (F.lane == 0) (isv ? F.SV : F.SU)[rr] = scale; }
}
__device__ __forceinline__ int tab_row0(const TabCtx& F, int stage) { return 4 * (stage * F.ngw + F.gw); }
__device__ __forceinline__ int tab_stages(const TabCtx& F) { return (2 * NEXP + 4 * F.ngw - 1) / (4 * F.ngw); }
__device__ __forceinline__ void xcd_barrier_steal(const XcdBarrier& b) {
    asm volatile("s_waitcnt vmcnt(0)" ::: "memory");
    __syncthreads();
    int tab_next = (int)b.st[8];
    volatile LAS unsigned* fl = b.st + 4;
    if (threadIdx.x == 0) {
        unsigned* bar = b.bar;
        __builtin_amdgcn_s_waitcnt(0);
        unsigned nloc = b.st[0], nx = b.st[1];
        if (nloc == 0u) { xcd_barrier_complete(bar, b.x, nloc, nx); b.st[0] = nloc; b.st[1] = nx; }
        const unsigned old = xb_add(&bar[XB_XSUB(b.x)], 1u);
        const unsigned gen = old / nloc;
        if (old + 1u == (gen + 1u) * nloc) {
            __builtin_amdgcn_fence(__ATOMIC_RELEASE, "agent");
            asm volatile("s_waitcnt vmcnt(0)" ::: "memory");
            const unsigned og = xb_add(&bar[XB_TOP], 1u);
            const unsigned tg = og / nx;
            if (og + 1u == (tg + 1u) * nx) xb_add(&bar[XB_TOPGEN], 1u);
            else XB_SPIN(xb_ld(&bar[XB_TOPGEN]) == tg, bar);
            __builtin_amdgcn_fence(__ATOMIC_ACQUIRE, "agent");
            xb_add(&bar[XB_XGEN(b.x)], 1u);
            asm volatile("s_waitcnt vmcnt(0)" ::: "memory");
            fl[0] = 1u;
        } else fl[0] = 0u;
        fl[1] = gen;
    }
    __syncthreads();
    if (fl[0] == 0u) {
        const TabCtx F = tab_ctx(b.st - 8);
        const int nst = tab_stages(F);
        f32x4 buf[4][4]; bool pending = false; int prow = 0;
        for (unsigned it = 0;; ++it) {
            if (threadIdx.x == 0) {
                unsigned open = xb_ld(&b.bar[XB_XGEN(b.x)]) != fl[1] ? 1u : 0u;
                if ((it & 63u) == 63u) { if (xb_ld(&b.bar[XB_TMO])) open = 1u; if (it > (XB_SPIN_CAP >> 2)) { atomicAdd(&b.bar[XB_TMO], 1u); open = 1u; } }
                fl[2] = open; }
            __syncthreads();
            const bool open = fl[2] != 0u;
            __syncthreads();
            if (pending) { tab_store(F, buf, prow); ++tab_next; pending = false; }
            if (open) break;
            if (tab_next < nst) { prow = tab_row0(F, tab_next); tab_load(F, buf, prow); pending = true; }
            else __builtin_amdgcn_s_sleep(4);
        }
        if (threadIdx.x == 0) { b.st[8] = (unsigned)tab_next; __builtin_amdgcn_fence(__ATOMIC_ACQUIRE, "agent"); asm volatile("s_waitcnt vmcnt(0)" ::: "memory"); }
    }
    __syncthreads();
}

__device__ __forceinline__ void load_mod_vectors(f32x4 (&gs)[4], f32x4 (&sh)[4], const float* g, const float* shift, const float* scale, int lane) {
#pragma unroll
    for (int j = 0; j < 4; ++j) { const f32x4 gg = ((const f32x4*)g)[lane + 64 * j], sc = ((const f32x4*)scale)[lane + 64 * j]; gs[j] = gg * (sc + 1.0f); sh[j] = ((const f32x4*)shift)[lane + 64 * j]; }
}
__device__ __forceinline__ f32x4 load_row4(const float* row, int i4) { return __builtin_nontemporal_load((const f32x4*)row + i4); }
__device__ __forceinline__ f32x4 load_row4(const bf16* row, int i4) { const v2u w = ((const v2u*)row)[i4]; return (f32x4){bflo(w.x), bfhi(w.x), bflo(w.y), bfhi(w.y)}; }
__device__ __forceinline__ f32x4 load_row4_nt(const float* row, int i4) { return load_row4(row, i4); }
__device__ __forceinline__ f32x4 load_row4_nt(const bf16* row, int i4) { const v2u w = __builtin_nontemporal_load((const v2u*)row + i4); return (f32x4){bflo(w.x), bfhi(w.x), bflo(w.y), bfhi(w.y)}; }
template <bool Q8, class TIN>
__device__ __forceinline__ void norm_mod_row(const TIN* xrow, bf16* orow, const f32x4 (&gs)[4], const f32x4 (&sh)[4], int lane, unsigned char* qrow = nullptr, float* qscale = nullptr) {
    f32x4 v[4]; float ss = 0.f;
#pragma unroll
    for (int j = 0; j < 4; ++j) { v[j] = load_row4_nt(xrow, lane + 64 * j); ss += (v[j].x * v[j].x + v[j].y * v[j].y) + (v[j].z * v[j].z + v[j].w * v[j].w); }
    ss = wave_sum(ss);
    const float rstd = 1.0f / sqrtf(ss * (1.0f / 1024.0f) + EPS);
    unsigned long long* o8 = (unsigned long long*)orow + lane;
    float am = 0.f;
#pragma unroll
    for (int j = 0; j < 4; ++j) {
        const f32x4 y = v[j] * rstd * gs[j] + sh[j];
        o8[64 * j] = (unsigned long long)pk2(y.x, y.y) | ((unsigned long long)pk2(y.z, y.w) << 32);
        if (Q8) { v[j] = y; am = fmaxf(am, fmaxf(fmaxf(fabsf(y.x), fabsf(y.y)), fmaxf(fabsf(y.z), fabsf(y.w)))); }
    }
    if (Q8) {
        am = wave_max(am);
        const float inv = am > 0.f ? 127.0f / am : 0.f;
#pragma unroll
        for (int j = 0; j < 4; ++j) ((unsigned*)qrow)[lane + 64 * j] = q8x4(v[j], inv, 0);
        if (lane == 0) *qscale = am * (1.0f / 127.0f);
    }
}

__device__ __forceinline__ int t5_bucket_rel(int rel) {
    const int n = rel < 0 ? -rel : rel; int v;
    if (n < 8) v = n; else if (n < 12) v = 8; else if (n < 16) v = 9; else if (n < 23) v = 10; else if (n < 32) v = 11;
    else if (n < 46) v = 12; else if (n < 64) v = 13; else if (n < 91) v = 14; else v = 15;
    return (rel > 0 ? 16 : 0) + v;
}
__device__ __forceinline__ bf16x8 pack8(const float* p) {
    v4u w; w.x = pk2(p[0], p[1]); w.y = pk2(p[2], p[3]); w.z = pk2(p[4], p[5]); w.w = pk2(p[6], p[7]);
    return __builtin_bit_cast(bf16x8, w);
}
struct KFrag { bf16x8 k[4]; };
struct VFrag { v4u v[2][2]; };
__device__ __forceinline__ void load_k(KFrag& f, const bf16* blk) {
#pragma unroll
    for (int s = 0; s < 4; ++s) f.k[s] = *(const bf16x8*)(blk + 512 * s);
}
__device__ __forceinline__ void load_v(VFrag& f, const bf16* blk) {
#pragma unroll
    for (int dt = 0; dt < 2; ++dt)
#pragma unroll
        for (int s = 0; s < 2; ++s) f.v[dt][s] = *(const v4u*)(blk + (dt * 2 + s) * 512);
}
__device__ __forceinline__ f32x16 score_tile(const KFrag& kf, const bf16x8 (&qf)[4], f32x16 st) {
#pragma unroll
    for (int s = 0; s < 4; ++s) st = MFMA32(kf.k[s], qf[s], st);
    return st;
}
template <int RANGE>
__device__ __forceinline__ void attn_tile_update(const float (&sv)[16], float& m_run, float& l_run, f32x16 (&o)[2], const VFrag& f) {
    constexpr int LO = RANGE == 2 ? 12 : 0, HI = RANGE == 1 ? 4 : 16;
    float mx = sv[LO];
#pragma unroll
    for (int i = LO + 1; i < HI; ++i) mx = fmaxf(mx, sv[i]);
    mx = xhalf_max(mx);
    const float m_new = fmaxf(m_run, mx);
    const float alpha = __builtin_amdgcn_exp2f(m_run - m_new);
    float p[16]; float ls = 0.f;
#pragma unroll
    for (int i = 0; i < 16; ++i) { if (i >= LO && i < HI) { p[i] = __builtin_amdgcn_exp2f(sv[i] - m_new); ls += p[i]; } else p[i] = 0.f; }
    l_run = l_run * alpha + ls; m_run = m_new;
    if (__builtin_amdgcn_ballot_w64(alpha != 1.0f) != 0ull) {
#pragma unroll
        for (int dt = 0; dt < 2; ++dt)
#pragma unroll
            for (int i = 0; i < 16; ++i) o[dt][i] *= alpha;
    }
    if (RANGE != 2) { const bf16x8 pf0 = pack8(p);
#pragma unroll
        for (int dt = 0; dt < 2; ++dt) o[dt] = MFMA32(__builtin_bit_cast(bf16x8, f.v[dt][0]), pf0, o[dt]); }
    if (RANGE != 1) { const bf16x8 pf1 = pack8(p + 8);
#pragma unroll
        for (int dt = 0; dt < 2; ++dt) o[dt] = MFMA32(__builtin_bit_cast(bf16x8, f.v[dt][1]), pf1, o[dt]); }
}
__device__ __forceinline__ void attn_finalize(Frame& F, f32x16 (&o)[2], float l_run, LAS float* ssq, const float* gain  , bf16* orow  , int head, int r, int h) {
    const float lt = xhalf_sum(l_run);
    const float inv = 1.0f / lt;
    float sq = 0.f;
#pragma unroll
    for (int dt = 0; dt < 2; ++dt)
#pragma unroll
        for (int i = 0; i < 16; ++i) { o[dt][i] *= inv; sq += o[dt][i] * o[dt][i]; }
    sq = xhalf_sum(sq);
    if (h == 0) ssq[head * 32 + r] = sq;
    __syncthreads();
    float tot = 0.f;
#pragma unroll
    for (int hd = 0; hd < 8; ++hd) tot += ssq[hd * 32 + r];
    const float rstd = 1.0f / sqrtf(tot * (1.0f / 512.0f) + EPS);
    __syncthreads();
#pragma unroll
    for (int dt = 0; dt < 2; ++dt)
#pragma unroll
        for (int g = 0; g < 4; ++g) {
            const int d = head * 64 + 32 * dt + 8 * g + 4 * h;
            const f32x4 gv = *(const f32x4*)(gain + d);
            v2u w; w.x = pk2(o[dt][4 * g] * rstd * gv.x, o[dt][4 * g + 1] * rstd * gv.y); w.y = pk2(o[dt][4 * g + 2] * rstd * gv.z, o[dt][4 * g + 3] * rstd * gv.w);
            *(v2u*)(orow + d) = w;
        }
}

__device__ __forceinline__ void attn_finalize2(f32x16 (&o)[2][2], const float (&l_run)[2], LAS float* ssq, const float* gain, bf16* orow, int head0, int r, int h) {
#pragma unroll
    for (int e = 0; e < 2; ++e) {
        const float lt = xhalf_sum(l_run[e]);
        const float inv = 1.0f / lt;
        float sq = 0.f;
#pragma unroll
        for (int dt = 0; dt < 2; ++dt)
#pragma unroll
            for (int i = 0; i < 16; ++i) { o[e][dt][i] *= inv; sq += o[e][dt][i] * o[e][dt][i]; }
        sq = xhalf_sum(sq);
        if (h == 0) ssq[(head0 + e) * 32 + r] = sq;
    }
    __syncthreads();
    float tot = 0.f;
#pragma unroll
    for (int hd = 0; hd < 8; ++hd) tot += ssq[hd * 32 + r];
    const float rstd = 1.0f / sqrtf(tot * (1.0f / 512.0f) + EPS);
    __syncthreads();
#pragma unroll
    for (int e = 0; e < 2; ++e)
#pragma unroll
        for (int dt = 0; dt < 2; ++dt)
#pragma unroll
            for (int g = 0; g < 4; ++g) {
                const int d = (head0 + e) * 64 + 32 * dt + 8 * g + 4 * h;
                const f32x4 gv = *(const f32x4*)(gain + d);
                v2u w; w.x = pk2(o[e][dt][4 * g] * rstd * gv.x, o[e][dt][4 * g + 1] * rstd * gv.y); w.y = pk2(o[e][dt][4 * g + 2] * rstd * gv.z, o[e][dt][4 * g + 3] * rstd * gv.w);
                *(v2u*)(orow + d) = w;
            }
}
__device__ __forceinline__ void attn_phase(Frame& F) {
    constexpr float LOG2E = 1.4426950408889634f;
    LAS float* tb = (LAS float*)F.lds;
    LAS float* rp = (LAS float*)(F.lds + 11264);
    LAS float* ssq = (LAS float*)(F.lds + 11264 + 61440);
    for (int i = F.tid; i < 8 * 352; i += NTHREADS) { const int hd = i / 352, rel = i % 352 - 160; tb[i] = (rel >= -128 && rel <= 128) ? F.t5[t5_bucket_rel(rel) * 8 + hd] * LOG2E : -1e30f; }
    for (int i = F.tid; i < 8 * 15 * 128; i += NTHREADS) { const int co = (i & 127) - 48, hr = i >> 7; rp[i] = (co >= 0 && co <= 30) ? F.rpb[hr * 31 + co] * LOG2E : 0.f; }
    __syncthreads();
    const int head = F.wave, kvh = head >> 2, r = F.lane & 31, h = F.lane >> 5;
    Fair fair; fair.init(F);
    const int vcu = (F.G % 8 == 0) ? (F.bx % 8) * (F.G / 8) + F.bx / 8 : F.bx;
    bf16x8 qnx[4]; KFrag knx;
#define ATTN_A_PREFETCH(U) do { const int u_ = (U) < 1024 ? (U) : vcu; const int b_ = u_ >> 8, q0_ = (u_ & 255) * 32, qt_ = (b_ * S + q0_) >> 5, lo_ = (q0_ >= 128) ? -4 : -(q0_ >> 5); \
        const bf16* qb_ = F.PROJ + (size_t)head * M * 64 + (size_t)qt_ * 2048 + F.lane * 8; \
        _Pragma("unroll") for (int s_ = 0; s_ < 4; ++s_) qnx[s_] = __builtin_nontemporal_load((const bf16x8*)(qb_ + 512 * s_)); \
        load_k(knx, F.PROJ + (size_t)(8 + kvh) * M * 64 + (size_t)(qt_ + lo_) * 2048 + F.lane * 8); } while (0)
    ATTN_A_PREFETCH(vcu);
    for (int unit = vcu; unit < 1024; unit += F.G) {
        const int b = unit >> 8, q0 = (unit & 255) * 32;
        const int qtile = (b * S + q0) >> 5;
        bf16x8 qf[4];
#pragma unroll
        for (int s = 0; s < 4; ++s) qf[s] = qnx[s];
        float m_run = F.sink[head] * LOG2E, l_run = (h == 0) ? 1.0f : 0.0f;
        f32x16 o[2];
#pragma unroll
        for (int dt = 0; dt < 2; ++dt)
#pragma unroll
            for (int i = 0; i < 16; ++i) o[dt][i] = 0.f;
        const int kt_lo = (q0 >= 128) ? -4 : -(q0 >> 5), kt_hi = (q0 + 32 + 128 <= S) ? 4 : ((S - 32 - q0) >> 5);
        const bf16* kbase = F.PROJ + (size_t)(8 + kvh) * M * 64 + (size_t)qtile * 2048 + F.lane * 8;
        const bf16* vbase = F.VT + (size_t)kvh * M * 64 + (size_t)qtile * 2048 + F.lane * 8;
        f32x16 st;
        const LAS float* tbl0 = tb + head * 352 + 160 - r + 4 * h;
        { KFrag k0 = knx; f32x16 ini;
#pragma unroll
          for (int i = 0; i < 16; ++i) ini[i] = tbl0[32 * kt_lo + (i & 3) + 8 * (i >> 2)];
          st = score_tile(k0, qf, ini); }
        for (int kt = kt_lo; kt <= kt_hi; ++kt) {
            const int ktn = kt < kt_hi ? kt + 1 : kt;
            fair.step();
            KFrag kn; VFrag vc;
            load_k(kn, kbase + (ptrdiff_t)ktn * 2048);
            load_v(vc, vbase + (ptrdiff_t)kt * 2048);
            f32x16 ini;
#pragma unroll
            for (int i = 0; i < 16; ++i) ini[i] = tbl0[32 * ktn + (i & 3) + 8 * (i >> 2)];
            float sv[16];
#pragma unroll
            for (int i = 0; i < 16; ++i) sv[i] = st[i];
            attn_tile_update<0>(sv, m_run, l_run, o, vc);
            st = score_tile(kn, qf, ini);
        }
        ATTN_A_PREFETCH(unit + F.G);
        attn_finalize(F, o, l_run, ssq, F.gna, F.MIX + (size_t)(b * S + q0 + r) * D, head, r, h);
    }
#undef ATTN_A_PREFETCH
    for (int unit = vcu; unit < 512; unit += F.G) {
        const int b = unit >> 7, rg = unit & 127;
        const int rs = (rg - 4) < 0 ? 0 : ((rg - 4) > 120 ? 120 : (rg - 4));
        bf16x8 qf[2][4]; unsigned vm[2]; int cq[2];
#pragma unroll
        for (int qh = 0; qh < 2; ++qh) {
            const int c = 32 * qh + r; cq[qh] = c;
            const int cs = (c - 8) < 0 ? 0 : ((c - 8) > 48 ? 48 : (c - 8));
            const bf16* qblk = F.PROJ + (size_t)(10 + head) * M * 64 + (size_t)(b * 256 + rg * 2 + qh) * 2048 + F.lane * 8;
#pragma unroll
            for (int s = 0; s < 4; ++s) qf[qh][s] = __builtin_nontemporal_load((const bf16x8*)(qblk + 512 * s));
            unsigned m = 0u;
#pragma unroll
            for (int ct = 0; ct < 2; ++ct)
#pragma unroll
                for (int i = 0; i < 16; ++i) { const int kc = ct * 32 + (i & 3) + 8 * (i >> 2) + 4 * h; m |= (kc >= cs && kc < cs + 16) ? (1u << (16 * ct + i)) : 0u; }
            vm[qh] = m;
        }
        float m_run[2] = {-1e30f, -1e30f}, l_run[2] = {0.0f, 0.0f};
        f32x16 o[2][2];
#pragma unroll
        for (int qh = 0; qh < 2; ++qh)
#pragma unroll
            for (int dt = 0; dt < 2; ++dt)
#pragma unroll
                for (int i = 0; i < 16; ++i) o[qh][dt][i] = 0.f;
        const bf16* kbase = F.PROJ + (size_t)(18 + head) * M * 64 + (size_t)(b * 256 + rs * 2) * 2048 + F.lane * 8;
        const bf16* vbase = F.VT + (size_t)(2 + head) * M * 64 + (size_t)(b * 256 + rs * 2) * 2048 + F.lane * 8;
        f32x16 st[2];
#define NB_INIT(dst, qh, kr_, ct_) do { const LAS float* _rp = rp + (head * 15 + ((kr_) - rg + 7)) * 128 + 48 + (ct_) * 32 + 4 * h - cq[qh] + 15; const unsigned _vm = vm[qh] >> (16 * (ct_)); \
            _Pragma("unroll") for (int i = 0; i < 16; ++i) dst[i] = ((_vm >> i) & 1u) ? _rp[(i & 3) + 8 * (i >> 2)] : -1e30f; } while (0)
        { KFrag k0; load_k(k0, kbase); f32x16 i0, i1; NB_INIT(i0, 0, rs, 0); NB_INIT(i1, 1, rs, 0); st[0] = score_tile(k0, qf[0], i0); st[1] = score_tile(k0, qf[1], i1); }
#pragma unroll 1
        for (int kp = 0; kp < 8; ++kp) {
            const int kr = rs + kp;
#pragma unroll
            for (int ct = 0; ct < 2; ++ct) {
                const int kti = 2 * kp + ct;
                const int ktn = kti < 15 ? kti + 1 : kti;
                fair.step();
                KFrag kn; VFrag vc;
                load_k(kn, kbase + (size_t)ktn * 2048);
                load_v(vc, vbase + (size_t)kti * 2048);
                f32x16 i0, i1;
                if (ct == 0) { NB_INIT(i0, 0, kr, 1); NB_INIT(i1, 1, kr, 1); } else { NB_INIT(i0, 0, kr + 1, 0); NB_INIT(i1, 1, kr + 1, 0); }
#pragma unroll
                for (int qh = 0; qh < 2; ++qh) {
                    float sv[16];
#pragma unroll
                    for (int i = 0; i < 16; ++i) sv[i] = st[qh][i];
                    if (qh == 0 && ct == 1) attn_tile_update<1>(sv, m_run[qh], l_run[qh], o[qh], vc);
                    else if (qh == 1 && ct == 0) attn_tile_update<2>(sv, m_run[qh], l_run[qh], o[qh], vc);
                    else attn_tile_update<0>(sv, m_run[qh], l_run[qh], o[qh], vc);
                }
                st[0] = score_tile(kn, qf[0], i0); st[1] = score_tile(kn, qf[1], i1);
            }
        }
#undef NB_INIT
#pragma unroll
        for (int qh = 0; qh < 2; ++qh)
            attn_finalize(F, o[qh], l_run[qh], ssq, F.gnb, F.MIX + (size_t)(b * S + rg * 64 + cq[qh]) * D + 512, head, r, h);
    }
    fair.done();
}

__device__ __forceinline__ float tag_f(float v, unsigned tag, unsigned mask) { return __builtin_bit_cast(float, (__builtin_bit_cast(unsigned, v) & ~mask) | tag); }
#define CEX(a, b) do { const float _hi = fmaxf(a, b), _lo = fminf(a, b); a = _hi; b = _lo; } while (0)
template <int N> __device__ __forceinline__ void bitonic_sort_desc(float (&v)[N]) {
#pragma unroll
    for (int k = 2; k <= N; k <<= 1)
#pragma unroll
        for (int j = k >> 1; j > 0; j >>= 1)
#pragma unroll
            for (int i = 0; i < N; ++i) {
                const int l = i ^ j;
                if (l > i) { if ((i & k) == 0) { CEX(v[i], v[l]); } else { CEX(v[l], v[i]); } }
            }
}
__device__ __forceinline__ void bitonic_merge16_desc(float (&v)[16]) {
#pragma unroll
    for (int j = 8; j > 0; j >>= 1)
#pragma unroll
        for (int i = 0; i < 16; ++i) { const int l = i ^ j; if (l > i) CEX(v[i], v[l]); }
}
__device__ __forceinline__ void top16_merge(float (&a)[16], const float (&b)[16]) {
#pragma unroll
    for (int i = 0; i < 16; ++i) a[i] = fmaxf(a[i], b[15 - i]);
    bitonic_merge16_desc(a);
}
__device__ __forceinline__ void top16_pair(const f32x16 (&st)[4], int h, float (&out)[16]) {
    float g[4][16];
#pragma unroll
    for (int nt = 0; nt < 4; ++nt) {
#pragma unroll
        for (int i = 0; i < 16; ++i) g[nt][i] = tag_f(st[nt][i], (unsigned)(32 * nt + crow(i, h)), 127u);
        bitonic_sort_desc<16>(g[nt]);
    }
    top16_merge(g[0], g[1]); top16_merge(g[2], g[3]); top16_merge(g[0], g[2]);
    float th[16];
#pragma unroll
    for (int i = 0; i < 16; ++i) halves(g[0][i], out[i], th[i]);
    top16_merge(out, th);
}

__device__ __forceinline__ void route_phase(Frame& F) {
    const int r = F.lane & 31, h = F.lane >> 5;
    const int head = F.bx & 7;
    bf16x8 qf[8];
#define ROUTE_LOADQ(tg_, half_) do { const bf16* qblk_ = F.QP + (size_t)(head * 4 + (half_) * 2) * M * 64 + (size_t)((tg_) * 8 + F.wave) * 2048 + F.lane * 8; \
        _Pragma("unroll") for (int s_ = 0; s_ < 8; ++s_) qf[s_] = __builtin_nontemporal_load((const bf16x8*)(qblk_ + (size_t)(s_ >> 2) * M * 64 + (s_ & 3) * 512)); } while (0)
    ROUTE_LOADQ(F.bx >> 3, 0);
#pragma unroll 4
    for (int il = F.tid; il < 4096; il += NTHREADS) {
        const int i = head * 4096 + il;
        const int ln = i & 63, sk = (i >> 6) & 7, nt = (i >> 9) & 3, hh = i >> 11;
        const int n = 32 * nt + (ln & 31), d0 = 16 * sk + 8 * (ln >> 5);
        const f32x4* src = (const f32x4*)(F.sub_keys + ((size_t)hh * 128 + n) * 128 + d0);
        const f32x4 a = src[0], b = src[1];
        v4u o; o.x = pk2(a.x, a.y); o.y = pk2(a.z, a.w); o.z = pk2(b.x, b.y); o.w = pk2(b.z, b.w);
        ((LAS v4u*)F.lds)[il] = o;
    }
    __syncthreads();
    LAS int* scr = (LAS int*)(F.lds + 65536 + F.wave * 8192) + F.lane;
    Fair fair; fair.init(F);
    for (int tg = F.bx >> 3; tg < 128; tg += F.G >> 3) {
        const int t0 = (tg * 8 + F.wave) * 32;
        const int tgn = (tg + (F.G >> 3) < 128) ? tg + (F.G >> 3) : tg;
        float lst[2][16];
#pragma unroll
        for (int half = 0; half < 2; ++half) {
            fair.step();
            const LAS unsigned char* sk = F.lds + half * 32768 + F.lane * 16;
            f32x16 st[4];
#pragma unroll
            for (int nt = 0; nt < 4; ++nt) {
#pragma unroll
                for (int i = 0; i < 16; ++i) st[nt][i] = 0.f;
#pragma unroll
                for (int s = 0; s < 8; ++s) st[nt] = MFMA32(*(const LAS bf16x8*)(sk + (nt * 8 + s) * 1024), qf[s], st[nt]);
                __builtin_amdgcn_sched_barrier(0);
            }
            if (half == 0) ROUTE_LOADQ(tg, 1); else ROUTE_LOADQ(tgn, 0);
            __builtin_amdgcn_sched_barrier(0);
            top16_pair(st, h, lst[half]);
            __builtin_amdgcn_sched_barrier(0);
        }
#pragma unroll
        for (int i = 0; i < 16; ++i) { scr[i * 64] = (int)(__builtin_bit_cast(unsigned, lst[0][i]) & 127u); scr[(16 + i) * 64] = (int)(__builtin_bit_cast(unsigned, lst[1][i]) & 127u); }
        constexpr float NEGINF = -3.0e38f;
        float win[16], tmp[16];
#pragma unroll
        for (int j = 0; j < 16; ++j) win[j] = tag_f(lst[0][0] + lst[1][j], (unsigned)j, 255u);
#pragma unroll
        for (int i = 1; i < 8; ++i) {
#pragma unroll
            for (int j = 0; j < 16; ++j) tmp[j] = ((i + 1) * (j + 1) <= 16) ? tag_f(lst[0][i] + lst[1][j], (unsigned)(i * 16 + j), 255u) : NEGINF;
            top16_merge(win, tmp);
        }
#pragma unroll
        for (int j = 0; j < 16; ++j) tmp[j] = (j < 8) ? tag_f(lst[0][8 + j] + lst[1][0], (unsigned)((8 + j) * 16), 255u) : NEGINF;
        top16_merge(win, tmp);
        float e[16]; float es = 0.f;
#pragma unroll
        for (int k = 0; k < 16; ++k) { e[k] = __expf(win[k] - win[0]); es += e[k]; }
        const float einv = 1.0f / es;
        LDS_WAIT(); asm volatile("" ::: "memory");
        int ex[16];
#pragma unroll
        for (int k = 0; k < 16; ++k) { const unsigned code = __builtin_bit_cast(unsigned, win[k]) & 255u; ex[k] = scr[(code >> 4) * 64] * 128 + scr[(16 + (code & 15u)) * 64]; }
        if (h == 0) {
            int* ip = F.IDX + (size_t)(t0 + r) * 128 + head * 16; float* gp = F.GT + (size_t)(t0 + r) * 128 + head * 16;
#pragma unroll
            for (int k4 = 0; k4 < 4; ++k4) {
                *(v4u*)(ip + 4 * k4) = (v4u){(unsigned)ex[4 * k4], (unsigned)ex[4 * k4 + 1], (unsigned)ex[4 * k4 + 2], (unsigned)ex[4 * k4 + 3]};
                *(f32x4*)(gp + 4 * k4) = (f32x4){e[4 * k4] * einv, e[4 * k4 + 1] * einv, e[4 * k4 + 2] * einv, e[4 * k4 + 3] * einv};
            }
        }
        LDS_WAIT(); asm volatile("" ::: "memory");
    }
#undef ROUTE_LOADQ
    fair.done();
}

__device__ __forceinline__ float gelu_tanh(float z) {
    const float u = 0.7978845608028654f * (z + 0.044715f * z * z * z);
    const float t = 1.0f - 2.0f / (__expf(2.0f * u) + 1.0f);
    return 0.5f * z * (1.0f + t);
}
__device__ __forceinline__ int rev4(int k) { return ((k & 1) << 3) | ((k & 2) << 1) | ((k & 4) >> 1) | ((k & 8) >> 3); }
__device__ __forceinline__ int idot16(const v4u& a, const v4u& b) {
    int r = __builtin_amdgcn_sdot4((int)a.x, (int)b.x, 0, false); r = __builtin_amdgcn_sdot4((int)a.y, (int)b.y, r, false);
    r = __builtin_amdgcn_sdot4((int)a.z, (int)b.z, r, false); return __builtin_amdgcn_sdot4((int)a.w, (int)b.w, r, false);
}
__device__ __forceinline__ void fma4u(float (&acc)[16], int o, unsigned w, float a) {
    acc[o + 0] += a * (float)(w & 0xffu); acc[o + 1] += a * (float)((w >> 8) & 0xffu); acc[o + 2] += a * (float)((w >> 16) & 0xffu); acc[o + 3] += a * (float)(w >> 24);
}
constexpr int MB_IDX_PITCH = 528, MB_AUX_OFF = 8 * 528, MB_AUX_PITCH = 144, MB_BYTES = 6144;
struct VMeta { v4u n[4]; v4u a; };
__device__ __forceinline__ void v_gather(v4u (&vq)[16], const VMeta& m, const unsigned char* vbase, unsigned c16) {
#pragma unroll
    for (int i = 0; i < 16; ++i) vq[i] = *(const v4u*)(vbase + (unsigned)(m.n[i >> 2][i & 3] * 128u + c16));
}
__device__ __forceinline__ void v_accumulate(int (&acc)[16], const v4u (&vq)[16], const v4u al) {
#pragma unroll
    for (int a = 0; a < 4; ++a)
#pragma unroll
        for (int b = 0; b < 4; ++b) {
            const unsigned r0 = vq[4 * a + 0][b], r1 = vq[4 * a + 1][b], r2 = vq[4 * a + 2][b], r3 = vq[4 * a + 3][b];
            const unsigned t0 = __builtin_amdgcn_perm(r1, r0, 0x05010400u), t1 = __builtin_amdgcn_perm(r1, r0, 0x07030602u);
            const unsigned t2 = __builtin_amdgcn_perm(r3, r2, 0x05010400u), t3 = __builtin_amdgcn_perm(r3, r2, 0x07030602u);
            const unsigned c0 = __builtin_amdgcn_perm(t2, t0, 0x05040100u), c1 = __builtin_amdgcn_perm(t2, t0, 0x07060302u);
            const unsigned c2 = __builtin_amdgcn_perm(t3, t1, 0x05040100u), c3 = __builtin_amdgcn_perm(t3, t1, 0x07060302u);
            acc[4 * b + 0] = __builtin_amdgcn_sdot4((int)c0, (int)al[a], acc[4 * b + 0], false);
            acc[4 * b + 1] = __builtin_amdgcn_sdot4((int)c1, (int)al[a], acc[4 * b + 1], false);
            acc[4 * b + 2] = __builtin_amdgcn_sdot4((int)c2, (int)al[a], acc[4 * b + 2], false);
            acc[4 * b + 3] = __builtin_amdgcn_sdot4((int)c3, (int)al[a], acc[4 * b + 3], false);
        }
}

__device__ __forceinline__ void peer_fused_phase(Frame& F, bf16* pout) {
    int lane_ = F.lane; asm volatile("" : "+v"(lane_));
    const int lane = lane_, g = lane >> 3, c = lane & 7;
    const bool b0 = c & 1, b1 = c & 2, b2 = c & 4;
    const int i0c = 8 * (c & 1) + 4 * ((c >> 1) & 1) + 2 * ((c >> 2) & 1);
    LAS unsigned char* wl = F.lds + F.wave * 16384;
    constexpr int L_IDX = 0, L_AUXZ = 16 * MB_IDX_PITCH, L_AUXV = L_AUXZ + 2 * 8 * MB_AUX_PITCH;
    const int xcc = (int)(xb_xcc_id() & 7u);
    Fair fair; fair.init(F);
    for (int grp = F.gw; grp < M / 16; grp += F.ngw) {
    const int it0 = grp * 2;
    const int tkl = lane >> 3, q = lane & 7;
#pragma unroll
    for (int item = 0; item < 2; ++item) {
        const v4u* ip = (const v4u*)(F.IDX + (size_t)((it0 + item) * 8 + tkl) * 128 + 16 * q);
        const v4u a0 = ip[0], a1 = ip[1], a2 = ip[2], a3 = ip[3];
        LAS v4u* p = (LAS v4u*)(wl + L_IDX + (item * 8 + tkl) * MB_IDX_PITCH + q * 64);
        p[0] = a0; p[1] = a1; p[2] = a2; p[3] = a3;
    }
    int zacc[16][2];
#pragma unroll
    for (int i = 0; i < 16; ++i) { zacc[i][0] = 0; zacc[i][1] = 0; }
    {
        int buf = 0;
        { const v4u x0 = *(const v4u*)(F.X8 + (size_t)(it0 * 8 + tkl) * D + xcc * 128 + 16 * q); *(LAS v4u*)(wl + L_AUXZ + tkl * MB_AUX_PITCH + q * 16) = x0; }
#pragma unroll 1
        for (int k = 0; k < 8; ++k) {
            const int s = (xcc + k) & 7, sn = (xcc + k + 1) & 7;
            const unsigned char* ubase = F.U8 + (size_t)s * NEXP * 128;
#pragma unroll
            for (int item = 0; item < 2; ++item) {
                fair.step();
                const v4u xn = *(const v4u*)(F.X8 + (size_t)((item == 0 ? it0 + 1 : it0) * 8 + tkl) * D + (item == 0 ? s : sn) * 128 + 16 * q);
                const LAS unsigned char* ib = wl + L_IDX + item * 8 * MB_IDX_PITCH;
                const LAS unsigned char* xb = wl + L_AUXZ + buf * 8 * MB_AUX_PITCH;
#pragma unroll
                for (int tt = 0; tt < 8; ++tt) {
                    const LAS v4u* ip = (const LAS v4u*)(ib + tt * MB_IDX_PITCH + g * 64);
                    const v4u n0 = ip[0], n1 = ip[1], n2 = ip[2], n3 = ip[3];
                    const v4u xq = *(const LAS v4u*)(xb + tt * MB_AUX_PITCH + c * 16);
                    const unsigned e[16] = {n0.x, n0.y, n0.z, n0.w, n1.x, n1.y, n1.z, n1.w, n2.x, n2.y, n2.z, n2.w, n3.x, n3.y, n3.z, n3.w};
                    v4u uq[16];
#pragma unroll
                    for (int i = 0; i < 16; ++i) uq[i] = *(const v4u*)(ubase + (unsigned)(e[i] * 128u + (unsigned)c * 16u));
                    int p[16];
#pragma unroll
                    for (int i = 0; i < 16; ++i) p[i] = idot16(uq[i], xq);
                    int q8_[8], q4_[4], q2_[2];
#pragma unroll
                    for (int i = 0; i < 8; ++i) { const int keep = b0 ? p[8 + i] : p[i], send = b0 ? p[i] : p[8 + i]; q8_[i] = keep + dppi<DPP_XOR1>(send); }
#pragma unroll
                    for (int i = 0; i < 4; ++i) { const int keep = b1 ? q8_[4 + i] : q8_[i], send = b1 ? q8_[i] : q8_[4 + i]; q4_[i] = keep + dppi<DPP_XOR2>(send); }
#pragma unroll
                    for (int i = 0; i < 2; ++i) { const int keep = b2 ? q4_[2 + i] : q4_[i], send = b2 ? q4_[i] : q4_[2 + i]; q2_[i] = keep + __shfl_xor(send, 4); }
                    zacc[item * 8 + tt][0] += q2_[0]; zacc[item * 8 + tt][1] += q2_[1];
                }
                buf ^= 1;
                *(LAS v4u*)(wl + L_AUXZ + buf * 8 * MB_AUX_PITCH + tkl * MB_AUX_PITCH + q * 16) = xn;
                __builtin_amdgcn_sched_barrier(0);
            }
        }
    }
    {
        const int j0 = 16 * g + i0c;
        v2u ee[16]; float g0[16], g1[16], sxv[16], su0[16], su1[16], sv0[16], sv1[16];
#pragma unroll
        for (int tk = 0; tk < 16; ++tk) { const int t = it0 * 8 + tk;
            ee[tk] = *(const LAS v2u*)(wl + L_IDX + tk * MB_IDX_PITCH + j0 * 4);
            const float* gp = F.GT + (size_t)t * 128 + j0;
            g0[tk] = gp[0]; g1[tk] = gp[1]; sxv[tk] = F.SX[t]; }
#pragma unroll
        for (int tk = 0; tk < 16; ++tk) { su0[tk] = F.SU[ee[tk].x]; su1[tk] = F.SU[ee[tk].y]; sv0[tk] = F.SV[ee[tk].x]; sv1[tk] = F.SV[ee[tk].y]; }
        __builtin_amdgcn_sched_barrier(0);
#pragma unroll
        for (int tk = 0; tk < 16; ++tk) {
            const float a0 = gelu_tanh((float)zacc[tk][0] * (sxv[tk] * su0[tk])) * g0[tk] * sv0[tk];
            const float a1 = gelu_tanh((float)zacc[tk][1] * (sxv[tk] * su1[tk])) * g1[tk] * sv1[tk];
            const float am = wave_max(fmaxf(fabsf(a0), fabsf(a1)));
            const float inv = am > 0.f ? 127.0f / am : 0.f;
            *(LAS unsigned short*)(wl + L_AUXV + tk * MB_AUX_PITCH + j0) = (unsigned short)(q8(a0, inv, 0) | (q8(a1, inv, 0) << 8));
            zacc[tk][0] = __builtin_bit_cast(int, am * (1.0f / 127.0f));
        }
    }
    {
        const int tk = lane >> 3;
        float sa2[2];
#pragma unroll
        for (int item = 0; item < 2; ++item) { float v = 0.f;
#pragma unroll
            for (int j = 0; j < 8; ++j) v = (tk == j) ? __builtin_bit_cast(float, zacc[item * 8 + j][0]) : v;
            sa2[item] = v; }
#pragma unroll 1
        for (int k = 0; k < 8; ++k) {
            const int s = (xcc + k) & 7;
            const unsigned char* vbase = F.V8 + (size_t)s * NEXP * 128;
#pragma unroll
            for (int item = 0; item < 2; ++item) {
                fair.step();
                const LAS unsigned char* ib = wl + L_IDX + (item * 8 + tk) * MB_IDX_PITCH;
                const LAS unsigned char* ab = wl + L_AUXV + (item * 8 + tk) * MB_AUX_PITCH;
                const int t = (it0 + item) * 8 + tk;
                int acc[16];
#pragma unroll
                for (int i = 0; i < 16; ++i) acc[i] = 0;
                VMeta mt[2]; v4u vq[2][16];
#pragma unroll
                for (int u = 0; u < 2; ++u) { const LAS v4u* ip = (const LAS v4u*)(ib + u * 64); mt[u].n[0] = ip[0]; mt[u].n[1] = ip[1]; mt[u].n[2] = ip[2]; mt[u].n[3] = ip[3]; mt[u].a = *(const LAS v4u*)(ab + u * 16); }
                v_gather(vq[0], mt[0], vbase, (unsigned)c * 16u);
#pragma unroll
                for (int i = 0; i < 8; ++i) {
                    const int cur = i & 1, nxt = cur ^ 1;
                    const v4u al = mt[cur].a;
                    if (i + 1 < 8) v_gather(vq[nxt], mt[nxt], vbase, (unsigned)c * 16u);
                    if (i + 2 < 8) { const LAS v4u* ip = (const LAS v4u*)(ib + (i + 2) * 64); mt[cur].n[0] = ip[0]; mt[cur].n[1] = ip[1]; mt[cur].n[2] = ip[2]; mt[cur].n[3] = ip[3]; mt[cur].a = *(const LAS v4u*)(ab + (i + 2) * 16); }
                    v_accumulate(acc, vq[cur], al);
                }
                const float sa = sa2[item];
                v4u w0, w1;
                w0.x = pk2(sa * (float)acc[0], sa * (float)acc[1]);   w0.y = pk2(sa * (float)acc[2], sa * (float)acc[3]);
                w0.z = pk2(sa * (float)acc[4], sa * (float)acc[5]);   w0.w = pk2(sa * (float)acc[6], sa * (float)acc[7]);
                w1.x = pk2(sa * (float)acc[8], sa * (float)acc[9]);   w1.y = pk2(sa * (float)acc[10], sa * (float)acc[11]);
                w1.z = pk2(sa * (float)acc[12], sa * (float)acc[13]); w1.w = pk2(sa * (float)acc[14], sa * (float)acc[15]);
                v4u* po = (v4u*)(pout + (size_t)t * D + s * 128 + 16 * c);
                po[0] = w0; po[1] = w1;
                __builtin_amdgcn_sched_barrier(0);
            }
        }
    }
    fair.done();
    asm volatile("s_waitcnt vmcnt(0)" ::: "memory");
    {
        int ln = lane; asm volatile("" : "+v"(ln));
        const int tb = it0 * 8;
        const float* gate2 = F.ada + (size_t)(tb >> 13) * 6144 + 5120;
        f32x4 gt[4], gf[4];
#pragma unroll
        for (int j = 0; j < 4; ++j) { gt[j] = ((const f32x4*)gate2)[ln + 64 * j]; gf[j] = ((const f32x4*)F.gfin)[ln + 64 * j]; }
        for (int k = 0; k < 16; k += 2)
#pragma unroll
        for (int u2 = 0; u2 < 2; ++u2) { const int t = tb + k + u2;
            f32x4* xr = (f32x4*)(F.out + (size_t)t * D) + ln;
            const bf16* x1row = F.X1 + (size_t)t * D;
            const v2u* pr = (const v2u*)(pout + (size_t)t * D) + ln;
            f32x4 v[4]; float ss = 0.f;
#pragma unroll
            for (int j = 0; j < 4; ++j) {
                const f32x4 x1 = load_row4(x1row, ln + 64 * j); const v2u pw = pr[64 * j];
                f32x4 y; y.x = x1.x + gt[j].x * bflo(pw.x); y.y = x1.y + gt[j].y * bfhi(pw.x); y.z = x1.z + gt[j].z * bflo(pw.y); y.w = x1.w + gt[j].w * bfhi(pw.y);
                v[j] = y; ss += (y.x * y.x + y.y * y.y) + (y.z * y.z + y.w * y.w);
            }
            ss = wave_sum(ss);
            const float rstd = 1.0f / sqrtf(ss * (1.0f / 1024.0f) + EPS);
#pragma unroll
            for (int j = 0; j < 4; ++j) xr[64 * j] = v[j] * rstd * gf[j];
        }
    }
    }
}

__global__ void __launch_bounds__(NTHREADS, 2) hymba_fwd(Args args) {
    extern __shared__ __attribute__((aligned(16))) unsigned char lds[];
    Frame F;
    F.lds = (LAS unsigned char*)lds;
    F.tid = threadIdx.x; F.lane = F.tid & 63; F.wave = __builtin_amdgcn_readfirstlane(F.tid >> 6);
    F.G = gridDim.x; F.bx = blockIdx.x; F.gw = F.bx * NWAVES + F.wave; F.ngw = F.G * NWAVES;
    unsigned char* ws = args.ws;
    F.x = args.in[0]; F.c = args.in[1]; F.w_ada = args.in[2]; F.b_ada = args.in[3]; F.g1 = args.in[4]; F.w_in = args.in[5]; F.sink = args.in[6]; F.t5 = args.in[7];
    F.rpb = args.in[8]; F.gna = args.in[9]; F.gnb = args.in[10]; F.w_out = args.in[11]; F.g2 = args.in[12]; F.w_query = args.in[13]; F.sub_keys = args.in[14];
    F.uexp = args.in[15]; F.vexp = args.in[16]; F.gfin = args.in[17]; F.out = args.out;
    F.ada = (float*)(ws + WS_ADA); F.WO = (bf16*)(ws + WS_WO); F.WQ = (bf16*)(ws + WS_WQ); F.SK = (bf16*)(ws + WS_SK);
    F.W1A = (bf16*)(ws + WS_W1A); F.H = (bf16*)(ws + WS_H); F.WVT = (bf16*)(ws + WS_WVT); F.U8 = ws + WS_U8; F.V8 = ws + WS_V8; F.X8 = ws + WS_X8; F.SU = (float*)(ws + WS_SU); F.SV = (float*)(ws + WS_SV); F.SX = (float*)(ws + WS_SX); F.ctl = (unsigned*)(ws + WS_CTL); F.X1 = (bf16*)(ws + WS_X1);
    F.PROJ = (bf16*)(ws + WS_PROJ); F.VT = (bf16*)(ws + WS_VT); F.QP = (bf16*)(ws + WS_QP); F.MIX = (bf16*)(ws + WS_MIX); F.IDX = (int*)(ws + WS_IDX); F.GT = (float*)(ws + WS_G);

    volatile LAS unsigned* MISC = (volatile LAS unsigned*)(F.lds + MISC_OFF); F.MISC = MISC;
    if (F.tid < 32) MISC[F.tid] = 0u;
    __syncthreads();
    if (F.tid == 0) { volatile LAS unsigned long long* q = (volatile LAS unsigned long long*)(MISC + 18);
        q[0] = (unsigned long long)args.in[15]; q[1] = (unsigned long long)args.in[16]; q[2] = (unsigned long long)(ws + WS_U8); q[3] = (unsigned long long)(ws + WS_V8);
        q[4] = (unsigned long long)(ws + WS_SU); q[5] = (unsigned long long)(ws + WS_SV); }
    XcdBarrier bar = xcd_barrier_post((unsigned*)(ws + WS_CTL) + CW_BAR, MISC + 8);

    p0_prologue(F);
    if (F.tid == 0) {
        unsigned sp = 0;
        while (__hip_atomic_load(F.ctl + CW_ADA, __ATOMIC_RELAXED, __HIP_MEMORY_SCOPE_AGENT) < 256u) { __builtin_amdgcn_s_sleep(2); if (++sp > (1u << 22)) break; }
        __builtin_amdgcn_fence(__ATOMIC_ACQUIRE, "agent");
        asm volatile("s_waitcnt vmcnt(0)" ::: "memory");
    }
    __syncthreads();
    {
        int ln = F.lane; asm volatile("" : "+v"(ln));
        const int wpb = F.ngw >> 2, qb = F.gw / wpb, wq = F.gw - qb * wpb;
        if (qb < NB) {
            const float* ad = F.ada + (size_t)qb * 6144;
            f32x4 gs[4], sh[4]; load_mod_vectors(gs, sh, F.g1, ad, ad + 1024, ln);
            for (int r = wq; r < S; r += 2 * wpb) {
#pragma unroll
                for (int u = 0; u < 2; ++u) { const int rr = r + u * wpb; if (rr < S) { const int mm = qb * S + rr; norm_mod_row<false, float>(F.x + (size_t)mm * D, F.H + (size_t)mm * D, gs, sh, ln); } } }
        }
    }
    xcd_barrier_steal(bar);
    { pg8::Gemm g{F.H, F.W1A, M + NVT, N1A + M, D, D, D}; pg8::Gemm1Order So; So.init(F.G, F.bx);
      pg8::EpiGemm1 E{pg8::EpiQKFrag{F.PROJ, M}, pg8::EpiVTFrag{F.VT, M}};
      pg8::gemm_phase<pg8::EpiGemm1, pg8::Gemm1Order, true, true>(F.lds, g, So, E); }
    xcd_barrier_steal(bar);
    attn_phase(F);
    xcd_barrier_steal(bar);
    { pg8::Gemm g{F.MIX, F.WO, M, D, D, D, D}; pg8::StaticOrder So; So.init(M, D, F.G, F.bx); pg8::EpiResGate E{F.x, F.ada, F.X1};
      pg8::gemm_phase<pg8::EpiResGate, pg8::StaticOrder, true, true>(F.lds, g, So, E); }
    xcd_barrier_steal(bar);
    {
        int ln = F.lane; asm volatile("" : "+v"(ln));
        const int wpb = F.ngw >> 2, qb = F.gw / wpb, wq = F.gw - qb * wpb;
        if (qb < NB) {
            const float* ad = F.ada + (size_t)qb * 6144;
            f32x4 gs[4], sh[4]; load_mod_vectors(gs, sh, F.g2, ad + 3072, ad + 4096, ln);
            for (int r = wq; r < S; r += 2 * wpb) {
#pragma unroll
                for (int u = 0; u < 2; ++u) { const int rr = r + u * wpb; if (rr < S) { const int mm = qb * S + rr; norm_mod_row<true, bf16>(F.X1 + (size_t)mm * D, F.H + (size_t)mm * D, gs, sh, ln, F.X8 + (size_t)mm * D, F.SX + mm); } } }
        }
    }
    xcd_barrier_steal(bar);
    { pg8::Gemm g{F.H, F.WQ, M, NQ, D, D, D}; pg8::StaticOrder So; So.init(M, NQ, F.G, F.bx); pg8::EpiQKFrag E{F.QP, M};
      pg8::gemm_phase<pg8::EpiQKFrag, pg8::StaticOrder, true, true>(F.lds, g, So, E); }
    xcd_barrier_steal(bar);
    route_phase(F);
    { const TabCtx T = tab_ctx(F.MISC); for (int tab_next = (int)F.MISC[16], nst = tab_stages(T); tab_next < nst; ++tab_next) { f32x4 buf[4][4]; const int r0 = tab_row0(T, tab_next); tab_load(T, buf, r0); tab_store(T, buf, r0); } }
    xcd_barrier(bar);
    peer_fused_phase(F, F.MIX);
}

extern "C" void kernel_launch(void* const* d_in, const int* in_sizes, int n_in, void* d_out, int out_size, void* d_ws, size_t ws_size, hipStream_t stream) {
    static int grid = 0;
    if (grid == 0) {
        if (n_in != 18 || out_size != M * D || ws_size < WS_END) { fprintf(stderr, "kernel_launch: unexpected shapes (n_in %d out %d ws %zu)\n", n_in, out_size, ws_size); grid = -1; return; }
        int dev = 0, cus = 0, per_cu = 0;
        if (hipGetDevice(&dev) != hipSuccess || hipDeviceGetAttribute(&cus, hipDeviceAttributeMultiprocessorCount, dev) != hipSuccess) { grid = -1; return; }
        if (hipFuncSetAttribute((const void*)hymba_fwd, hipFuncAttributeMaxDynamicSharedMemorySize, LDS_BYTES) != hipSuccess) { fprintf(stderr, "kernel_launch: hipFuncSetAttribute failed\n"); grid = -1; return; }
        if (hipOccupancyMaxActiveBlocksPerMultiprocessor(&per_cu, (const void*)hymba_fwd, NTHREADS, LDS_BYTES) != hipSuccess || per_cu < 1) { fprintf(stderr, "kernel_launch: occupancy query says %d\n", per_cu); per_cu = 1; }
        (void)hipGetLastError();
        grid = cus;
    }
    if (grid < 0) return;
    if (hipMemsetAsync((char*)d_ws + WS_CTL, 0, CTL_ZERO_BYTES, stream) != hipSuccess) return;
    Args a{};
    for (int i = 0; i < 18; ++i) a.in[i] = (const float*)d_in[i];
    a.out = (float*)d_out; a.ws = (unsigned char*)d_ws;
    hipLaunchKernelGGL(hymba_fwd, dim3(grid), dim3(NTHREADS), LDS_BYTES, stream, a);
}
```
